# Optimizing an MI355X kernel written in HIP

```python
import math
import jax, jax.numpy as jnp
from jax import lax
import numpy as np

D_MODEL = 1024
BATCH = 4
SEQ = 4096
DEPTH = 4

CHUNK = 64
Q_BLOCK = 128
N_HEADS = 8
HEAD_DIM = 64
V_DIM = 2 * HEAD_DIM
QK_WIDTH = N_HEADS * 2 * HEAD_DIM
ATTN_WIDTH = N_HEADS * V_DIM
ROT_DIM = HEAD_DIM // 4
ROPE_THETA = 500000.0
CONV_WIDTH = D_MODEL
CONV_K = 3
D_FF = -(-8 * D_MODEL // (3 * 256)) * 256
IN_WIDTH = 3 * QK_WIDTH + 3 * CONV_WIDTH + 2 * D_MODEL
SPLITS = tuple(int(v) for v in np.cumsum([QK_WIDTH, QK_WIDTH, ATTN_WIDTH, CONV_WIDTH, CONV_WIDTH, CONV_WIDTH, D_MODEL]))
NORM_EPS = 1e-6
NEG_INF = -1e30

kernel_name = "chunk_causal_hybrid_diffattn_shortconv"


def rms_norm(x, w):
    xf = x.astype(jnp.float32)
    y = xf * lax.rsqrt(jnp.mean(xf * xf, axis=-1, keepdims=True) + NORM_EPS)
    return (y * w.astype(jnp.float32)).astype(x.dtype)


def rope_tables(positions):
    freqs = ROPE_THETA ** (-jnp.arange(0, ROT_DIM, 2, dtype=jnp.float32) / ROT_DIM)
    ang = positions.astype(jnp.float32)[..., None] * freqs
    return jnp.cos(ang), jnp.sin(ang)


def apply_partial_rope(t, cos, sin):
    c = cos[:, :, None, None, :]
    s = sin[:, :, None, None, :]
    rot = t[..., :ROT_DIM].astype(jnp.float32)
    x1, x2 = rot[..., : ROT_DIM // 2], rot[..., ROT_DIM // 2:]
    r = jnp.concatenate([x1 * c - x2 * s, x2 * c + x1 * s], axis=-1)
    return jnp.concatenate([r.astype(t.dtype), t[..., ROT_DIM:]], axis=-1)


def diff_attention(q, k, v, chunk_id, lam):
    b, s = q.shape[0], q.shape[1]
    nb = s // Q_BLOCK
    scale = HEAD_DIM ** -0.5
    kt = k.transpose(0, 2, 3, 1, 4)
    vt = v.transpose(0, 2, 1, 3)
    qb = q.reshape(b, nb, Q_BLOCK, N_HEADS, 2, HEAD_DIM).transpose(1, 0, 3, 4, 2, 5)
    qcb = chunk_id.reshape(b, nb, Q_BLOCK).transpose(1, 0, 2)

    def block(args):
        qi, qci = args
        sc = jnp.einsum('bhmqd,bhmkd->bhmqk', qi, kt).astype(jnp.float32) * scale
        allowed = chunk_id[:, None, :] <= qci[:, :, None]
        sc = jnp.where(allowed[:, None, None], sc, NEG_INF)
        p = jax.nn.softmax(sc, axis=-1)
        a = p[:, :, 0] - lam * p[:, :, 1]
        return jnp.einsum('bhqk,bhkd->bhqd', a.astype(vt.dtype), vt)

    o = lax.map(block, (qb, qcb))
    return o.transpose(1, 0, 3, 2, 4).reshape(b, s, N_HEADS, V_DIM)


def causal_dwconv(u, w):
    return lax.conv_general_dilated(
        u, w[:, None, :].astype(u.dtype), window_strides=(1,),
        padding=[(CONV_K - 1, 0)], dimension_numbers=('NWC', 'WIO', 'NWC'),
        feature_group_count=u.shape[-1])


def setup_inputs(seed: int = 0) -> dict:
    key = jax.random.key(seed)
    ks = jax.random.split(key, 20)
    f32 = jnp.float32

    def nrm(k, shape, fan_in):
        return jax.random.normal(k, shape, f32) * (fan_in ** -0.5)

    x = jax.random.normal(ks[0], (BATCH, SEQ, D_MODEL), f32)
    start = jax.random.randint(ks[1], (BATCH, 1), 0, 64, dtype=jnp.int32) * CHUNK
    positions = start + jnp.arange(SEQ, dtype=jnp.int32)[None, :]
    return {
        "x": x,
        "positions": positions,
        "mix_norm": 1.0 + 0.01 * jax.random.normal(ks[2], (DEPTH, D_MODEL), f32),
        "w_in": nrm(ks[3], (DEPTH, D_MODEL, IN_WIDTH), D_MODEL),
        "lambda_q1": 0.1 * jax.random.normal(ks[4], (DEPTH, HEAD_DIM), f32),
        "lambda_k1": 0.1 * jax.random.normal(ks[5], (DEPTH, HEAD_DIM), f32),
        "lambda_q2": 0.1 * jax.random.normal(ks[6], (DEPTH, HEAD_DIM), f32),
        "lambda_k2": 0.1 * jax.random.normal(ks[7], (DEPTH, HEAD_DIM), f32),
        "subln_w": 1.0 + 0.01 * jax.random.normal(ks[8], (DEPTH, V_DIM), f32),
        "conv_w": nrm(ks[9], (DEPTH, CONV_K, CONV_WIDTH), CONV_K),
        "w_branch_a": nrm(ks[10], (DEPTH, ATTN_WIDTH, D_MODEL), ATTN_WIDTH),
        "w_branch_b": nrm(ks[11], (DEPTH, CONV_WIDTH, D_MODEL), CONV_WIDTH),
        "w_out": nrm(ks[12], (DEPTH, D_MODEL, D_MODEL), D_MODEL),
        "ffn_norm": 1.0 + 0.01 * jax.random.normal(ks[13], (DEPTH, D_MODEL), f32),
        "w_gate": nrm(ks[14], (DEPTH, D_MODEL, D_FF), D_MODEL),
        "w_up": nrm(ks[15], (DEPTH, D_MODEL, D_FF), D_MODEL),
        "w_down": nrm(ks[16], (DEPTH, D_FF, D_MODEL), D_FF),
        "final_norm": 1.0 + 0.01 * jax.random.normal(ks[17], (D_MODEL,), f32),
    }


def reference(x, positions, mix_norm, w_in, lambda_q1, lambda_k1, lambda_q2, lambda_k2,
              subln_w, conv_w, w_branch_a, w_branch_b, w_out, ffn_norm,
              w_gate, w_up, w_down, final_norm):
    b, s, _ = x.shape
    cos, sin = rope_tables(positions)
    chunk_id = positions // CHUNK
    for l in range(DEPTH):
        lambda_init = 0.8 - 0.6 * math.exp(-0.3 * l)
        xn = rms_norm(x, mix_norm[l])
        proj = xn @ w_in[l]
        q, k, v, bg, cg, u, ga, gb = jnp.split(proj, SPLITS, axis=-1)
        q = apply_partial_rope(q.reshape(b, s, N_HEADS, 2, HEAD_DIM), cos, sin)
        k = apply_partial_rope(k.reshape(b, s, N_HEADS, 2, HEAD_DIM), cos, sin)
        v = v.reshape(b, s, N_HEADS, V_DIM)
        lam = (jnp.exp(jnp.sum(lambda_q1[l].astype(jnp.float32) * lambda_k1[l].astype(jnp.float32)))
               - jnp.exp(jnp.sum(lambda_q2[l].astype(jnp.float32) * lambda_k2[l].astype(jnp.float32)))
               + lambda_init)
        o = diff_attention(q, k, v, chunk_id, lam)
        o = rms_norm(o, subln_w[l]) * (1.0 - lambda_init)
        y_a = o.reshape(b, s, ATTN_WIDTH) @ w_branch_a[l]
        y_b = (bg * causal_dwconv(cg * u, conv_w[l])) @ w_branch_b[l]
        mixed = jax.nn.sigmoid(ga) * y_a + jax.nn.sigmoid(gb) * y_b
        x = x + mixed @ w_out[l]
        hn = rms_norm(x, ffn_norm[l])
        x = x + (jax.nn.silu(hn @ w_gate[l]) * (hn @ w_up[l])) @ w_down[l]
    return rms_norm(x, final_norm)
```

```cpp
#include <hip/hip_runtime.h>
#include <hip/hip_cooperative_groups.h>
#include <cstdio>
#include <cstdint>
namespace cg = cooperative_groups;
namespace pg8 {
#define PG8_LAS __attribute__((address_space(3)))
typedef unsigned short bf16_t;
typedef short bf16x8 __attribute__((ext_vector_type(8)));
typedef float f32x4 __attribute__((ext_vector_type(4)));
typedef unsigned u32x4 __attribute__((ext_vector_type(4)));
constexpr int BM = 256, BK = 64, HALF = 128, HTB = HALF * BK * 2  , STAGE_BYTES = 8 * HTB, NXCD = 8, WGM = 8;

__host__ __device__ __forceinline__ int lds_byte(int r, int c) { const int st = (r >> 4) * 2 + (c >> 5), rr = r & 15, cc = c & 31, ob = rr * 64 + cc * 2; return st * 1024 + (ob ^ (((ob >> 9) & 1) << 5)); }
__host__ __device__ __forceinline__ void stage_rc(int b, int& R, int& C) { const int st = b / 1024, sb = b % 1024, swz = sb ^ (((sb >> 9) & 1) << 5); R = (st >> 1) * 16 + swz / 64; C = (st & 1) * 32 + (swz % 64) / 2; }
__host__ __device__ __forceinline__ int perm32(int rho) { const int n = rho >> 4, i = rho & 15; return 8 * (i >> 2) + 4 * n + (i & 3); }

struct Unit { int pm, pn; };
struct Gemm { const bf16_t* A; const bf16_t* Bt; int M, N, K; const bf16_t* A2 = nullptr; const bf16_t* Bt2 = nullptr; };

struct StaticOrder {
    int nM, nN, nwg, G, c;
    __host__ __device__ void init(int M, int N, int G_, int c_) { nM = M / BM; nN = N / BM; nwg = nM * nN; G = G_; c = c_; }
    __host__ __device__ bool next(int i, Unit& u) const {
        const long L = (long)i * G + c; if (L >= nwg) return false;
        int wgid = (int)L; { const int q = nwg / NXCD, r = nwg % NXCD, xcd = wgid % NXCD, off = wgid / NXCD; wgid = (xcd < r ? xcd * (q + 1) : r * (q + 1) + (xcd - r) * q) + off; }
        const int nig = WGM * nN, gid = wgid / nig, fm = gid * WGM, gsz = (nM - fm) < WGM ? (nM - fm) : WGM;
        u.pm = fm + ((wgid % nig) % gsz); u.pn = (wgid % nig) / gsz; return true;
    }
    __device__ __forceinline__ void a_ready(const Unit&) const {}
    __device__ __forceinline__ void done(const Unit&) const {}
};

__device__ __forceinline__ unsigned cvt_pk_bf16(float lo, float hi) { unsigned r; asm volatile("s_nop 3\n\tv_cvt_pk_bf16_f32 %0, %1, %2" : "=v"(r) : "v"(lo), "v"(hi)); return r; }
typedef float f32x2 __attribute__((ext_vector_type(2)));
typedef unsigned u32x2 __attribute__((ext_vector_type(2)));
__device__ __forceinline__ u32x4 pack8(const f32x4 v0, const f32x4 v1) { u32x4 w; w.x = cvt_pk_bf16(v0[0], v0[1]); w.y = cvt_pk_bf16(v0[2], v0[3]); w.z = cvt_pk_bf16(v1[0], v1[1]); w.w = cvt_pk_bf16(v1[2], v1[3]); return w; }
__device__ __forceinline__ float bf_lo(unsigned w) { return __uint_as_float(w << 16); }
__device__ __forceinline__ float bf_hi(unsigned w) { return __uint_as_float(w & 0xffff0000u); }
__device__ __forceinline__ void unpack8(const u32x4 w, f32x4& v0, f32x4& v1) { v0 = (f32x4){bf_lo(w.x), bf_hi(w.x), bf_lo(w.y), bf_hi(w.y)}; v1 = (f32x4){bf_lo(w.z), bf_hi(w.z), bf_lo(w.w), bf_hi(w.w)}; }
__device__ __forceinline__ float row_rstd(const float* ssq, int row) {
    const f32x4* p = (const f32x4*)(ssq + (size_t)row * 16);
    const f32x4 s = (p[0] + p[1]) + (p[2] + p[3]);
    return __builtin_amdgcn_rsqf(((s[0] + s[1]) + (s[2] + s[3])) * (1.0f / 1024.0f) + 1e-6f);
}
__device__ __forceinline__ float shfl_xor_l(float v, int mask, int lane) { return __builtin_bit_cast(float, __builtin_amdgcn_ds_bpermute((lane ^ mask) << 2, __builtin_bit_cast(int, v))); }
__device__ __forceinline__ float sigm(float v) { return __builtin_amdgcn_rcpf(1.0f + __expf(-v)); }

struct EpiProj {
    static constexpr bool PERM = true, AFTER_DRAIN = false;
    bf16_t* base; size_t stride; const float* ssq; const float* rope; float qscale; int pm0; const PG8_LAS float* rtab;
    __device__ __forceinline__ void operator()(const f32x4 (&acc)[2][2][4][2], const Unit& u, int wr, int wc, int fr_in, int fq_in) const {
        int fr = fr_in, fq = fq_in; asm volatile("" : "+v"(fr), "+v"(fq));
        const int colt = u.pn * BM, sec = colt >> 11, row0 = u.pm * BM + wr * 64 + fr;
        float rstd[2][4];
        if (u.pm == pm0) {
#pragma unroll
            for (int ai = 0; ai < 2; ++ai)
#pragma unroll
                for (int m = 0; m < 4; ++m) rstd[ai][m] = rtab[ai * HALF + wr * 64 + m * 16 + fr];
        } else {
#pragma unroll
            for (int ai = 0; ai < 2; ++ai)
#pragma unroll
                for (int m = 0; m < 4; ++m) rstd[ai][m] = row_rstd(ssq, row0 + ai * HALF + m * 16);
        }
        if (sec == 0) {
            const int t = colt >> 10;
            bf16_t* O = base + (size_t)t * stride + (colt & 1023) + wc * 32 + 8 * fq;
            const bool dorope = ((wc & 1) == 0) && (fq < 2);
            const int rofs = dorope ? 4 * fq : 0;
            const float sc = (t == 0) ? qscale : 1.0f;
#pragma unroll
            for (int ai = 0; ai < 2; ++ai) {
                f32x4 c4[4], s4[4];
#pragma unroll
                for (int m = 0; m < 4; ++m) { const float* rp = rope + (size_t)(row0 + ai * HALF + m * 16) * 16 + rofs; c4[m] = *(const f32x4*)rp; s4[m] = *(const f32x4*)(rp + 8); }
#pragma unroll
                for (int m = 0; m < 4; ++m) {
                    const f32x4 cc = dorope ? c4[m] : (f32x4){1.f, 1.f, 1.f, 1.f}, ss = dorope ? s4[m] : (f32x4){0.f, 0.f, 0.f, 0.f};
                    const float rs = rstd[ai][m] * sc;
                    bf16_t* rowp = O + (size_t)(row0 + ai * HALF + m * 16) * 1024;
#pragma unroll
                    for (int bj = 0; bj < 2; ++bj) {
                        const f32x4 v0 = acc[ai][bj][m][0] * rs, v1 = acc[ai][bj][m][1] * rs;
                        *(u32x4*)(rowp + bj * HALF) = pack8(v0 * cc - v1 * ss, v1 * cc + v0 * ss);
                    }
                }
            }
        } else if (sec == 1) {
            const int t = colt >> 10;
            bf16_t* O = base + (size_t)t * stride + (colt & 1023) + wc * 32 + 8 * fq;
#pragma unroll
            for (int ai = 0; ai < 2; ++ai)
#pragma unroll
                for (int m = 0; m < 4; ++m) {
                    bf16_t* rowp = O + (size_t)(row0 + ai * HALF + m * 16) * 1024;
#pragma unroll
                    for (int bj = 0; bj < 2; ++bj) *(u32x4*)(rowp + bj * HALF) = pack8(acc[ai][bj][m][0] * rstd[ai][m], acc[ai][bj][m][1] * rstd[ai][m]);
                }
        } else {
            const int cb = ((colt & 2047) >> 8) * 128 + wc * 32 + 8 * fq;
            if (sec == 2) {
#pragma unroll
                for (int ai = 0; ai < 2; ++ai)
#pragma unroll
                    for (int m = 0; m < 4; ++m) {
                        const float r2 = rstd[ai][m] * rstd[ai][m];
                        *(u32x4*)(base + 4 * stride + (size_t)(row0 + ai * HALF + m * 16) * 1024 + cb) = pack8(acc[ai][0][m][0] * acc[ai][1][m][0] * r2, acc[ai][0][m][1] * acc[ai][1][m][1] * r2);
                    }
            } else {
#pragma unroll
                for (int ai = 0; ai < 2; ++ai)
#pragma unroll
                    for (int m = 0; m < 4; ++m) {
                        const size_t off = (size_t)(row0 + ai * HALF + m * 16) * 1024 + cb;
                        f32x4 a0 = acc[ai][0][m][0] * rstd[ai][m], a1 = acc[ai][0][m][1] * rstd[ai][m], b0 = acc[ai][1][m][0] * rstd[ai][m], b1 = acc[ai][1][m][1] * rstd[ai][m];
#pragma unroll
                        for (int e = 0; e < 4; ++e) {
                            const float eb0 = 1.0f + __expf(-b0[e]), eb1 = 1.0f + __expf(-b1[e]);
                            a0[e] = eb0 * __builtin_amdgcn_rcpf(1.0f + __expf(-a0[e])); a1[e] = eb1 * __builtin_amdgcn_rcpf(1.0f + __expf(-a1[e]));
                            b0[e] = __builtin_amdgcn_rcpf(eb0); b1[e] = __builtin_amdgcn_rcpf(eb1); }
                        *(u32x4*)(base + 6 * stride + off) = pack8(a0, a1);
                        *(u32x4*)(base + 7 * stride + off) = pack8(b0, b1);
                    }
            }
        }
    }
};
struct EpiMix2 {
    static constexpr bool PERM = true, AFTER_DRAIN = false;
    const bf16_t* rat; const bf16_t* sgb; bf16_t* mixed;
    __device__ __forceinline__ void mid(f32x4 (&acc)[2][2][4][2], const Unit& u, int wr, int wc, int fr_in, int fq_in) const {
        int fr = fr_in, fq = fq_in; asm volatile("" : "+v"(fr), "+v"(fq));
        const bf16_t* gp = rat + (size_t)(u.pm * BM + wr * 64 + fr) * 1024 + u.pn * BM + wc * 32 + 8 * fq;
        u32x4 g[2][4][2];
#pragma unroll
        for (int ai = 0; ai < 2; ++ai)
#pragma unroll
            for (int m = 0; m < 4; ++m)
#pragma unroll
                for (int bj = 0; bj < 2; ++bj) g[ai][m][bj] = *(const u32x4*)(gp + (size_t)(ai * HALF + m * 16) * 1024 + bj * HALF);
#pragma unroll
        for (int ai = 0; ai < 2; ++ai)
#pragma unroll
            for (int m = 0; m < 4; ++m)
#pragma unroll
                for (int bj = 0; bj < 2; ++bj) { f32x4 g0, g1; unpack8(g[ai][m][bj], g0, g1); acc[ai][bj][m][0] = acc[ai][bj][m][0] * g0; acc[ai][bj][m][1] = acc[ai][bj][m][1] * g1; }
    }
    __device__ __forceinline__ void operator()(const f32x4 (&acc)[2][2][4][2], const Unit& u, int wr, int wc, int fr_in, int fq_in) const {
        int fr = fr_in, fq = fq_in; asm volatile("" : "+v"(fr), "+v"(fq));
        const size_t off0 = (size_t)(u.pm * BM + wr * 64 + fr) * 1024 + u.pn * BM + wc * 32 + 8 * fq;
        u32x4 g[2][4][2];
#pragma unroll
        for (int ai = 0; ai < 2; ++ai)
#pragma unroll
            for (int m = 0; m < 4; ++m)
#pragma unroll
                for (int bj = 0; bj < 2; ++bj) g[ai][m][bj] = *(const u32x4*)(sgb + off0 + (size_t)(ai * HALF + m * 16) * 1024 + bj * HALF);
#pragma unroll
        for (int ai = 0; ai < 2; ++ai)
#pragma unroll
            for (int m = 0; m < 4; ++m)
#pragma unroll
                for (int bj = 0; bj < 2; ++bj) { f32x4 g0, g1; unpack8(g[ai][m][bj], g0, g1);
                    *(u32x4*)(mixed + off0 + (size_t)(ai * HALF + m * 16) * 1024 + bj * HALF) = pack8(acc[ai][bj][m][0] * g0, acc[ai][bj][m][1] * g1); }
    }
};
struct EpiResid {
    static constexpr bool PERM = true, AFTER_DRAIN = false;
    bf16_t* xb; float* ssq;
    __device__ __forceinline__ void operator()(const f32x4 (&acc)[2][2][4][2], const Unit& u, int wr, int wc, int fr_in, int fq_in) const {
        int fr = fr_in, fq = fq_in; asm volatile("" : "+v"(fr), "+v"(fq));
        const int row0 = u.pm * BM + wr * 64 + fr, ln_ = fr + 16 * fq;
        bf16_t* xp = xb + (size_t)row0 * 1024 + u.pn * BM + wc * 32 + 8 * fq;
        u32x4 xv[2][4][2];
#pragma unroll
        for (int ai = 0; ai < 2; ++ai)
#pragma unroll
            for (int m = 0; m < 4; ++m)
#pragma unroll
                for (int bj = 0; bj < 2; ++bj) xv[ai][m][bj] = *(const u32x4*)(xp + (size_t)(ai * HALF + m * 16) * 1024 + bj * HALF);
#pragma unroll
        for (int ai = 0; ai < 2; ++ai)
#pragma unroll
            for (int m = 0; m < 4; ++m) {
                float ss = 0.f;
#pragma unroll
                for (int bj = 0; bj < 2; ++bj) {
                    f32x4 x0, x1; unpack8(xv[ai][m][bj], x0, x1);
                    const f32x4 v0 = x0 + acc[ai][bj][m][0], v1 = x1 + acc[ai][bj][m][1];
                    *(u32x4*)(xp + (size_t)(ai * HALF + m * 16) * 1024 + bj * HALF) = pack8(v0, v1);
                    ss += (v0[0] * v0[0] + v0[1] * v0[1]) + (v0[2] * v0[2] + v0[3] * v0[3]) + (v1[0] * v1[0] + v1[1] * v1[1]) + (v1[2] * v1[2] + v1[3] * v1[3]);
                }
                ss += shfl_xor_l(ss, 16, ln_); ss += shfl_xor_l(ss, 32, ln_);
                ssq[(size_t)(row0 + ai * HALF + m * 16) * 16 + u.pn * 4 + wc] = ss;
            }
    }
};
struct EpiSwiGLU {
    static constexpr bool PERM = true, AFTER_DRAIN = false;
    bf16_t* act; int ldc; const float* ssq; int pm0; const PG8_LAS float* rtab;
    __device__ __forceinline__ void operator()(const f32x4 (&acc)[2][2][4][2], const Unit& u, int wr, int wc, int fr_in, int fq_in) const {
        int fr = fr_in, fq = fq_in; asm volatile("" : "+v"(fr), "+v"(fq));
        const int row0 = u.pm * BM + wr * 64 + fr;
        float rstd[2][4];
        if (u.pm == pm0) {
#pragma unroll
            for (int ai = 0; ai < 2; ++ai)
#pragma unroll
                for (int m = 0; m < 4; ++m) rstd[ai][m] = rtab[ai * HALF + wr * 64 + m * 16 + fr];
        } else {
#pragma unroll
            for (int ai = 0; ai < 2; ++ai)
#pragma unroll
                for (int m = 0; m < 4; ++m) rstd[ai][m] = row_rstd(ssq, row0 + ai * HALF + m * 16);
        }
#pragma unroll
        for (int ai = 0; ai < 2; ++ai)
#pragma unroll
            for (int m = 0; m < 4; ++m) {
                f32x4 o[2];
#pragma unroll
                for (int n = 0; n < 2; ++n) {
                    const f32x4 g = acc[ai][0][m][n] * rstd[ai][m], up = acc[ai][1][m][n] * rstd[ai][m];
#pragma unroll
                    for (int e = 0; e < 4; ++e) o[n][e] = g[e] * sigm(g[e]) * up[e];
                }
                *(u32x4*)(act + (size_t)(row0 + ai * HALF + m * 16) * ldc + u.pn * HALF + wc * 32 + 8 * fq) = pack8(o[0], o[1]);
            }
    }
};
template <class Epi, class Sched, bool ALIGN_EPI = false, bool SP2 = false, bool SPLITK = false>
__device__ __forceinline__ void gemm_phase(PG8_LAS unsigned char* lds, const Gemm g, const Sched& S, const Epi& E) {
    int tid_l = threadIdx.x; asm volatile("" : "+v"(tid_l));
    const int tid = tid_l, wid = __builtin_amdgcn_readfirstlane(tid >> 6), lane = tid & 63, wr = wid >> 2, wc = wid & 3, fr = lane & 15, fq = lane >> 4;
    const int K = g.K, nt1 = K / BK, nt = SPLITK ? 2 * nt1 : nt1;
    unsigned voffA[2], voffB[2];
#pragma unroll
    for (int i = 0; i < 2; ++i) { int R, C; stage_rc(tid * 16 + i * 8192, R, C); const int Rb = Epi::PERM ? ((R & ~31) + perm32(R & 31)) : R;
        voffA[i] = (unsigned)(R * K + C) * 2u; voffB[i] = (unsigned)(Rb * K + C) * 2u; }
    const size_t kstep = (size_t)(BK * 2);
    const size_t hstep = (size_t)HALF * K * 2;
    const size_t tstep = 2 * hstep;
    const unsigned ldsw = (unsigned)wid * 1024u;
    const int aoff = lds_byte(wr * 64 + fr, fq * 8), boff = lds_byte(wc * 32 + fr, fq * 8);
#define PG8_SA(b, h) (((b) * 2 + (h)) * HTB)
#define PG8_SB(b, h) ((4 + (b) * 2 + (h)) * HTB)
#define PG8_STAGE(bufoff, gbase, voff) do { _Pragma("unroll") for (int _i = 0; _i < 2; ++_i) \
        __builtin_amdgcn_global_load_lds((const unsigned*)((const char*)(gbase) + (voff)[_i]), (PG8_LAS unsigned*)(lds + (bufoff) + ldsw + _i * 8192), 16, 0, 0); } while (0)
#define PG8_LDA(dst, b, h) do { _Pragma("unroll") for (int m = 0; m < 4; ++m) _Pragma("unroll") for (int k = 0; k < 2; ++k) dst[m][k] = *(const PG8_LAS bf16x8*)(lds + PG8_SA(b, h) + aoff + m * 2048 + k * 1024); } while (0)
#define PG8_LDB(dst, b, h) do { _Pragma("unroll") for (int n = 0; n < 2; ++n) _Pragma("unroll") for (int k = 0; k < 2; ++k) dst[n][k] = *(const PG8_LAS bf16x8*)(lds + PG8_SB(b, h) + boff + n * 2048 + k * 1024); } while (0)
#define PG8_MMA(ai, bj, At, Bt) do { __builtin_amdgcn_s_setprio(1); _Pragma("unroll") for (int m = 0; m < 4; ++m) _Pragma("unroll") for (int n = 0; n < 2; ++n) _Pragma("unroll") for (int k = 0; k < 2; ++k) \
        acc[ai][bj][m][n] = __builtin_amdgcn_mfma_f32_16x16x32_bf16(Bt[n][k], At[m][k], acc[ai][bj][m][n], 0, 0, 0); __builtin_amdgcn_s_setprio(0); } while (0)
#define PG8_WAIT_V(n) asm volatile("s_waitcnt vmcnt(" #n ")" ::: "memory")
#define PG8_WAIT_L(n) asm volatile("s_waitcnt lgkmcnt(" #n ")" ::: "memory")
#define PG8_BAR __builtin_amdgcn_s_barrier()
#define PG8_SCHED __builtin_amdgcn_sched_barrier(0)
    Unit cur, nxt; int ui = 0;
    if (!S.next(0, cur)) return;
    f32x4 acc[2][2][4][2];
#pragma unroll
    for (int a = 0; a < 2; ++a)
#pragma unroll
        for (int b = 0; b < 2; ++b)
#pragma unroll
            for (int m = 0; m < 4; ++m)
#pragma unroll
                for (int n = 0; n < 2; ++n) acc[a][b][m][n] = (f32x4){0.f, 0.f, 0.f, 0.f};
    bf16x8 At[4][2], B0[2][2], B1[2][2];
    const char* cA = (const char*)g.A + (size_t)cur.pm * tstep; const char* cB = (const char*)g.Bt + (size_t)cur.pn * tstep;
    const char* cA2 = SPLITK ? (const char*)g.A2 + (size_t)cur.pm * tstep : cA; const char* cB2 = SPLITK ? (const char*)g.Bt2 + (size_t)cur.pn * tstep : cB;
#define PG8_TA(tt) ((SPLITK && (tt) >= nt1) ? cA2 + (size_t)((tt) - nt1) * kstep : cA + (size_t)(tt) * kstep)
#define PG8_TB(tt) ((SPLITK && (tt) >= nt1) ? cB2 + (size_t)((tt) - nt1) * kstep : cB + (size_t)(tt) * kstep)
    S.a_ready(cur);
    if constexpr (SP2) {
        PG8_STAGE(PG8_SB(0, 0), cB, voffB); PG8_STAGE(PG8_SB(0, 1), cB + hstep, voffB); PG8_STAGE(PG8_SA(0, 0), cA, voffA); PG8_STAGE(PG8_SA(0, 1), cA + hstep, voffA);
        PG8_STAGE(PG8_SB(1, 0), cB + kstep, voffB); PG8_STAGE(PG8_SA(1, 0), cA + kstep, voffA); PG8_STAGE(PG8_SB(1, 1), cB + hstep + kstep, voffB);
        if (wr == 1) PG8_BAR;
        PG8_WAIT_V(8); PG8_BAR;
        PG8_WAIT_V(6); PG8_BAR;
    } else {
        PG8_STAGE(PG8_SB(0, 0), cB, voffB); PG8_STAGE(PG8_SA(0, 0), cA, voffA); PG8_STAGE(PG8_SB(0, 1), cB + hstep, voffB); PG8_STAGE(PG8_SA(0, 1), cA + hstep, voffA);
        if (wr == 1) PG8_BAR;
        PG8_WAIT_V(4); PG8_BAR;
        PG8_STAGE(PG8_SB(1, 0), cB + kstep, voffB); PG8_STAGE(PG8_SA(1, 0), cA + kstep, voffA); PG8_STAGE(PG8_SB(1, 1), cB + hstep + kstep, voffB);
        PG8_WAIT_V(6); PG8_BAR;
    }
    for (;;) {
        const bool has_next = S.next(ui + 1, nxt);
        const char* nA = has_next ? (const char*)g.A + (size_t)nxt.pm * tstep : cA; const char* nB = has_next ? (const char*)g.Bt + (size_t)nxt.pn * tstep : cB;
        for (int t = 0; t < nt; t += 2) {
            const bool last = (t == nt - 2);
            if constexpr (SPLITK) { if (t == nt1) E.mid(acc, cur, wr, wc, fr, fq); }
            const char* a1 = PG8_TA(t + 1);
            const char* a2 = last ? nA : PG8_TA(t + 2); const char* b2 = last ? nB : PG8_TB(t + 2);
            const char* a3 = a2 + kstep; const char* b3 = b2 + kstep;
            if (last && has_next) S.a_ready(nxt);
            if constexpr (SP2) {
            PG8_LDB(B0, 0, 0); PG8_LDB(B1, 0, 1); PG8_SCHED; PG8_LDA(At, 0, 0); PG8_STAGE(PG8_SA(1, 1), a1 + hstep, voffA);
            PG8_WAIT_V(8); PG8_WAIT_L(0); PG8_BAR; PG8_MMA(0, 0, At, B0); PG8_MMA(0, 1, At, B1); PG8_BAR; PG8_SCHED;
            PG8_LDA(At, 0, 1); PG8_STAGE(PG8_SB(0, 0), b2, voffB); PG8_STAGE(PG8_SB(0, 1), b2 + hstep, voffB); PG8_STAGE(PG8_SA(0, 0), a2, voffA);
            PG8_WAIT_V(8); PG8_WAIT_L(0); PG8_BAR; PG8_MMA(1, 0, At, B0); PG8_MMA(1, 1, At, B1); PG8_BAR; PG8_SCHED;
            PG8_LDB(B0, 1, 0); PG8_LDB(B1, 1, 1); PG8_SCHED; PG8_LDA(At, 1, 0); PG8_STAGE(PG8_SA(0, 1), a2 + hstep, voffA);
            PG8_WAIT_V(8); PG8_WAIT_L(0); PG8_BAR; PG8_MMA(0, 0, At, B0); PG8_MMA(0, 1, At, B1); PG8_BAR; PG8_SCHED;
            PG8_LDA(At, 1, 1); PG8_STAGE(PG8_SB(1, 0), b3, voffB); PG8_STAGE(PG8_SB(1, 1), b3 + hstep, voffB); PG8_STAGE(PG8_SA(1, 0), a3, voffA);
            PG8_WAIT_V(8); PG8_WAIT_L(0); PG8_BAR; PG8_MMA(1, 0, At, B0); PG8_MMA(1, 1, At, B1); PG8_BAR; PG8_SCHED;
            } else {
            PG8_LDB(B0, 0, 0); PG8_SCHED; PG8_LDA(At, 0, 0); PG8_STAGE(PG8_SA(1, 1), a1 + hstep, voffA);
            PG8_WAIT_L(8); PG8_BAR; PG8_WAIT_L(0); PG8_MMA(0, 0, At, B0); PG8_BAR; PG8_SCHED;
            PG8_LDB(B1, 0, 1); PG8_STAGE(PG8_SB(0, 0), b2, voffB);
            PG8_BAR; PG8_WAIT_L(0); PG8_MMA(0, 1, At, B1); PG8_BAR;
            PG8_LDA(At, 0, 1); PG8_STAGE(PG8_SA(0, 0), a2, voffA);
            PG8_BAR; PG8_WAIT_L(0); PG8_MMA(1, 0, At, B0); PG8_BAR; PG8_SCHED;
            PG8_STAGE(PG8_SB(0, 1), b2 + hstep, voffB);
            PG8_WAIT_V(6); PG8_BAR; PG8_MMA(1, 1, At, B1); PG8_BAR;
            PG8_LDB(B0, 1, 0); PG8_SCHED; PG8_LDA(At, 1, 0); PG8_STAGE(PG8_SA(0, 1), a2 + hstep, voffA);
            PG8_WAIT_L(8); PG8_BAR; PG8_WAIT_L(0); PG8_MMA(0, 0, At, B0); PG8_BAR; PG8_SCHED;
            PG8_LDB(B1, 1, 1); PG8_STAGE(PG8_SB(1, 0), b3, voffB);
            PG8_BAR; PG8_WAIT_L(0); PG8_MMA(0, 1, At, B1); PG8_BAR;
            PG8_LDA(At, 1, 1); PG8_STAGE(PG8_SA(1, 0), a3, voffA);
            PG8_BAR; PG8_WAIT_L(0); PG8_MMA(1, 0, At, B0); PG8_BAR; PG8_SCHED;
            PG8_STAGE(PG8_SB(1, 1), b3 + hstep, voffB);
            PG8_WAIT_V(6); PG8_BAR; PG8_MMA(1, 1, At, B1); PG8_BAR;
            }
        }
        if constexpr (ALIGN_EPI) { if (wr == 0) PG8_BAR; }
        if constexpr (!Epi::AFTER_DRAIN) { E(acc, cur, wr, wc, fr, fq); S.done(cur); }
        if (!has_next) break;
#pragma unroll
        for (int a = 0; a < 2; ++a)
#pragma unroll
            for (int b = 0; b < 2; ++b)
#pragma unroll
                for (int m = 0; m < 4; ++m)
#pragma unroll
                    for (int n = 0; n < 2; ++n) acc[a][b][m][n] = (f32x4){0.f, 0.f, 0.f, 0.f};
        cur = nxt; cA = nA; cB = nB; ++ui;
        if constexpr (SPLITK) { cA2 = (const char*)g.A2 + (size_t)cur.pm * tstep; cB2 = (const char*)g.Bt2 + (size_t)cur.pn * tstep; }
        if constexpr (ALIGN_EPI) { if (wr == 1) PG8_BAR; }
    }
    PG8_WAIT_V(0);
    if constexpr (!ALIGN_EPI) { if (wr == 0) PG8_BAR; }
    PG8_BAR;
    if constexpr (Epi::AFTER_DRAIN) { E.fused(acc, cur, wr, wc, fr, fq, lds, wid, lane); S.done(cur); }
#undef PG8_TA
#undef PG8_TB
#undef PG8_SA
#undef PG8_SB
#undef PG8_STAGE
#undef PG8_LDA
#undef PG8_LDB
#undef PG8_MMA
#undef PG8_WAIT_V
#undef PG8_WAIT_L
#undef PG8_BAR
#undef PG8_SCHED
}
}

#ifndef PG8_SP2
#define PG8_SP2 true
#endif
#ifndef PG8_ALIGN
#define PG8_ALIGN true
#endif
#include <hip/hip_bf16.h>
#include <cmath>
namespace attn_body {
using bf16=__hip_bfloat16;
using bf16x8=__attribute__((ext_vector_type(8)))short;
using s16x4=__attribute__((ext_vector_type(4)))short;
using f32x16=__attribute__((ext_vector_type(16)))float;
using u32x4=__attribute__((ext_vector_type(4)))unsigned;
constexpr int BATCH=4,NHEAD=16,SEQ=4096,D=64,DM=NHEAD*D;
constexpr int NW=8,QBLK=32,QB=QBLK*NW,KVBLK=64,NQB=SEQ/QB;
constexpr int ATTN_PITCH=DM, ATTN_UNIT_ROWS=QB;
__device__ __forceinline__ int crow(int r,int hi){return (r&3)+8*(r>>2)+4*hi;}
#define SBAR() __builtin_amdgcn_sched_barrier(0)
__device__ __forceinline__ void cmask(f32x16&p0,f32x16&p1,int jb,int qrel,int hi){
  const float NEG=-INFINITY; (void)hi;
  #pragma unroll
  for(int r=0;r<16;++r){ if(jb>(qrel>>6)){p0[r]=NEG; p1[r]=NEG;} }
}

constexpr int NSLOT=3, SLOTB=8192;
constexpr int LDS_K=0, LDS_V=NSLOT*SLOTB, LDS_WS=3*NSLOT*SLOTB, LDS_OST=LDS_WS+NW*64*4, LDS_BYTES=LDS_OST+NW*4096;
constexpr float C2=0.125f*1.4426950408889634f;
__device__ __forceinline__ void glds16(const void*gsrc,unsigned lds_dst){unsigned keep;
  asm volatile("s_mov_b32 %0, m0\n\ts_mov_b32 m0, %2\n\ts_nop 0\n\tglobal_load_lds_dwordx4 %1, off\n\ts_mov_b32 m0, %0":"=&s"(keep):"v"(gsrc),"s"(lds_dst):"memory");}
__device__ __forceinline__ float max3f(float a,float b,float c){float r;asm("v_max3_f32 %0, %1, %2, %3":"=v"(r):"v"(a),"v"(b),"v"(c));return r;}
__device__ __forceinline__ float max2f(float a,float b){float r;asm("v_max_f32_e32 %0, %1, %2":"=v"(r):"v"(a),"v"(b));return r;}
__device__ __forceinline__ float fadd_s(float a,float b){float r;asm("v_add_f32_e32 %0, %1, %2":"=v"(r):"v"(a),"v"(b));return r;}
__device__ __forceinline__ float fsub_s(float a,float b){float r;asm("v_sub_f32_e32 %0, %1, %2":"=v"(r):"v"(a),"v"(b));return r;}
typedef float f32x2_t __attribute__((ext_vector_type(2))); typedef __bf16 bf16x2_t __attribute__((ext_vector_type(2)));
__device__ __forceinline__ unsigned cvtpk_s(float lo,float hi){f32x2_t v={lo,hi};bf16x2_t b=__builtin_convertvector(v,bf16x2_t);return __builtin_bit_cast(unsigned,b);}
#define WAIT_BAR(N) asm volatile("s_waitcnt vmcnt(" #N ") lgkmcnt(0)\n\ts_barrier":::"memory")

__device__ __forceinline__ void qkt(f32x16&p0,f32x16&p1,const char*Kslot,const bf16x8*qr,const f32x16&negm,int r32,int hi){
  const char*kb=Kslot+hi*1024+r32*16;
  #pragma unroll
  for(int d0=0;d0<4;++d0){
    const bf16x8 b0=*reinterpret_cast<const bf16x8*>(kb+d0*2048);
    const bf16x8 b1=*reinterpret_cast<const bf16x8*>(kb+d0*2048+512);
    if(d0==0){p0=__builtin_amdgcn_mfma_f32_32x32x16_bf16(b0,qr[0],negm,0,0,0);p1=__builtin_amdgcn_mfma_f32_32x32x16_bf16(b1,qr[0],negm,0,0,0);}
    else{p0=__builtin_amdgcn_mfma_f32_32x32x16_bf16(b0,qr[d0],p0,0,0,0);p1=__builtin_amdgcn_mfma_f32_32x32x16_bf16(b1,qr[d0],p1,0,0,0);}}
}
typedef __attribute__((address_space(3))) const char* lds_cptr;
typedef short v4i16_t __attribute__((ext_vector_type(4)));
__device__ __forceinline__ void kload8(bf16x8*kf,lds_cptr kp){
  kf[0]=*(const __attribute__((address_space(3))) bf16x8*)(kp);      kf[1]=*(const __attribute__((address_space(3))) bf16x8*)(kp+512);
  kf[2]=*(const __attribute__((address_space(3))) bf16x8*)(kp+2048); kf[3]=*(const __attribute__((address_space(3))) bf16x8*)(kp+2560);
  kf[4]=*(const __attribute__((address_space(3))) bf16x8*)(kp+4096); kf[5]=*(const __attribute__((address_space(3))) bf16x8*)(kp+4608);
  kf[6]=*(const __attribute__((address_space(3))) bf16x8*)(kp+6144); kf[7]=*(const __attribute__((address_space(3))) bf16x8*)(kp+6656);
}
__device__ __forceinline__ void kload2(bf16x8*kf,lds_cptr kp,int j){ kf[2*j]=*(const __attribute__((address_space(3))) bf16x8*)(kp+j*2048); kf[2*j+1]=*(const __attribute__((address_space(3))) bf16x8*)(kp+j*2048+512); }
__device__ __forceinline__ s16x4 vtr(lds_cptr p){ return __builtin_bit_cast(s16x4,__builtin_amdgcn_ds_read_tr16_b64_v4i16((__attribute__((address_space(3))) v4i16_t*)p)); }
__device__ __forceinline__ float rowmax(const f32x16&p0,const f32x16&p1){
  float a=max3f(p0[0],p0[1],p1[0]),b=max3f(p0[2],p0[3],p1[1]);a=max3f(a,p1[2],p1[3]);
  #pragma unroll
  for(int r=4;r<16;r+=4){a=max3f(a,p0[r],p0[r+1]);b=max3f(b,p0[r+2],p0[r+3]);a=max3f(a,p1[r],p1[r+1]);b=max3f(b,p1[r+2],p1[r+3]);}
  const float m=max2f(a,b);
  auto rr=__builtin_amdgcn_permlane32_swap(__float_as_uint(m),__float_as_uint(m),false,false);
  return max2f(__uint_as_float(rr[0]),__uint_as_float(rr[1]));
}
__device__ __forceinline__ void pv(f32x16*o,int vb,bf16x8 pa0,bf16x8 pa1,bf16x8 pa2,bf16x8 pa3){
  #pragma unroll
  for(int d0=0;d0<4;++d0){s16x4 lo[4],hi[4];
    #pragma unroll
    for(int ks=0;ks<4;++ks){
      asm volatile("ds_read_b64_tr_b16 %0,%1 offset:%c2":"=&v"(lo[ks]):"v"(vb),"i"(d0*4096+ks*1024):"memory");
      asm volatile("ds_read_b64_tr_b16 %0,%1 offset:%c2":"=&v"(hi[ks]):"v"(vb),"i"(d0*4096+ks*1024+512):"memory");}
    asm volatile("s_waitcnt lgkmcnt(0)":::"memory");SBAR();
    #define PK(k) (bf16x8){lo[k][0],lo[k][1],lo[k][2],lo[k][3],hi[k][0],hi[k][1],hi[k][2],hi[k][3]}
    o[d0]=__builtin_amdgcn_mfma_f32_32x32x16_bf16(pa0,PK(0),o[d0],0,0,0);
    o[d0]=__builtin_amdgcn_mfma_f32_32x32x16_bf16(pa1,PK(1),o[d0],0,0,0);
    o[d0]=__builtin_amdgcn_mfma_f32_32x32x16_bf16(pa2,PK(2),o[d0],0,0,0);
    o[d0]=__builtin_amdgcn_mfma_f32_32x32x16_bf16(pa3,PK(3),o[d0],0,0,0);
    #undef PK
  }
}

#ifndef ATTN_STORE16
#define ATTN_STORE16(p,v) (*(u32x4*)(p)=(v))
#endif
template<int THRL> __device__ __forceinline__ void attn_unit(int b,int hq,int vcol,int qb,const bf16*Q,const bf16*__restrict__ K,const bf16*__restrict__ V,bf16*O,char*shm){
  int tid_l=threadIdx.x; asm volatile("":"+v"(tid_l));
  const int tid=tid_l,lane=tid&63,r32=lane&31,hi=lane>>5; const int wid=__builtin_amdgcn_readfirstlane(tid>>6);
  const long rowbase=(long)b*SEQ; const int q0=qb*QB;
  const bf16*Qw=Q+(rowbase+q0+wid*QBLK)*DM+hq*D;
  const bf16*Kh=K+rowbase*DM+hq*D,*Vh=V+rowbase*DM+vcol;
  const unsigned lds0=(unsigned)(uintptr_t)shm;
  float*wsf=(float*)(shm+LDS_WS)+wid*64;
  const bf16*ksrc=Kh+(long)lane*DM+wid*8;
  const bf16*vsrc=Vh+(long)(16*(wid&3)+(lane>>2))*DM+(wid>>2)*32+(lane&3)*8;
  const unsigned kdst=lds0+LDS_K+wid*1024, vdst=lds0+LDS_V+wid*1024;
  #define DMA_K(t,slot) glds16(ksrc+(long)(t)*KVBLK*DM,(unsigned)__builtin_amdgcn_readfirstlane(kdst+(slot)))
  #define DMA_V(t,slot) do{ glds16(vsrc+(long)(t)*KVBLK*DM,(unsigned)__builtin_amdgcn_readfirstlane(vdst+2*(slot))); glds16(vsrc+(long)(t)*KVBLK*DM+64,(unsigned)__builtin_amdgcn_readfirstlane(vdst+2*(slot)+8192)); }while(0)
  const int vb0=(int)(lds0+LDS_V)+((lane>>4)&1)*32+(lane&3)*8+(4*hi+((lane&15)>>2))*64;
  const char*Kbase=shm+LDS_K; bf16x8 kf[8];
  const lds_cptr shm3=(lds_cptr)shm; const lds_cptr kp0=shm3+LDS_K+hi*1024+r32*16; const lds_cptr vp0=shm3+LDS_V+((lane>>4)&1)*32+(lane&3)*8+(4*hi+((lane&15)>>2))*64;
  const int NT=(q0+QB)/KVBLK;
  DMA_K(0,0);DMA_V(0,0);DMA_K(1,SLOTB);
  bf16x8 qr[4];
  #pragma unroll
  for(int d0=0;d0<4;++d0)qr[d0]=*reinterpret_cast<const bf16x8*>(&Qw[(long)r32*DM+d0*16+hi*8]);
  float mhat=0.f,l_reg=0.f;f32x16 o[4];o[0]=f32x16{};o[1]=f32x16{};o[2]=f32x16{};o[3]=f32x16{};f32x16 negm=f32x16{};asm volatile("":"+v"(negm));
  const int qrel=wid*QBLK+r32;
  #define CMASK(P0,P1,t) do{int jb_=(t)-(NT-4); if(jb_>=0)cmask(P0,P1,jb_,qrel,hi);}while(0)
  bool resc=false;
  #define START(P0,P1) do{ const float rm=rowmax(P0,P1); resc=false; \
    { const float dl=rm; mhat=fadd_s(mhat,dl); \
      _Pragma("unroll") for(int r=0;r<16;++r){P0[r]=fsub_s(P0[r],dl);P1[r]=fsub_s(P1[r],dl);} \
      _Pragma("unroll") for(int r=0;r<16;++r)negm[r]=-mhat; asm volatile("":"+v"(negm)); } \
    _Pragma("unroll") for(int r=0;r<16;++r)P0[r]=__builtin_amdgcn_exp2f(P0[r]); }while(0)
  #define RESC() do{ if(resc){ asm volatile("s_waitcnt lgkmcnt(0)":::"memory"); \
      _Pragma("unroll") for(int d_=0;d_<4;++d_) _Pragma("unroll") for(int r=0;r<16;++r)o[d_][r]*=wsf[crow(r,hi)]; } }while(0)
  f32x16 pA0,pA1,pB0,pB1;
  int sl_prev=0,sl_cur=0,sl_next=SLOTB;
  #define ROT() do{sl_prev=sl_cur;sl_cur=sl_next;sl_next=(sl_next==(NSLOT-1)*SLOTB)?0:sl_next+SLOTB;}while(0)
  DMA_K(2,2*SLOTB);
  WAIT_BAR(4);
  qkt(pA0,pA1,Kbase,qr,negm,r32,hi);asm volatile("s_nop 15\n\ts_nop 7":"+v"(pA0),"+v"(pA1));CMASK(pA0,pA1,0);
  START(pA0,pA1);
  _Pragma("unroll") for(int r=0;r<16;++r)pA1[r]=__builtin_amdgcn_exp2f(pA1[r]);
  WAIT_BAR(0);
  DMA_K(3,0);DMA_V(1,SLOTB);
  ROT();
  kload8(kf,kp0+sl_cur);
  WAIT_BAR(3);
  s16x4 vlo[4],vhi[4]; u32x4 pw0,pw1,pw2,pw3;
  #define PKW(P,B) cvtpk_s(P[B],P[B+1])
  #define PAF(k) __builtin_bit_cast(bf16x8,pw##k)
  #define VFR(i) (bf16x8){vlo[i][0],vlo[i][1],vlo[i][2],vlo[i][3],vhi[i][0],vhi[i][1],vhi[i][2],vhi[i][3]}
  #define VRDJ(d,ks) do{ vlo[d]=vtr(vp_+((d)*4096+(ks)*1024)); vhi[d]=vtr(vp_+((d)*4096+(ks)*1024+512)); }while(0)
  #define GAPB2(MF,X,B) do{ MF; X[B]=EX(X[B]); X[B+1]=EX(X[B+1]); PIN(X); SBAR(); }while(0)
  #define PVM(d,ks) o[d]=__builtin_amdgcn_mfma_f32_32x32x16_bf16(PAF(ks),VFR(d),o[d],0,0,0)
  #define PIN(x) asm volatile("":"+v"(x))
  #define MX3(a,b,c) __builtin_fmaxf(__builtin_fmaxf((a),(b)),(c))
  #define GAPA(MF,A0,A1,A2,A3,W0,W1,PW) do{ MF; sacc+=A0; sacc+=A1; sacc+=A2; sacc+=A3; PIN(sacc); W0; W1; PIN(PW); SBAR(); }while(0)
  #define EX(v) __builtin_amdgcn_exp2f(v)
  #define GAPB(MF,X,B) do{ MF; X[B]=EX(X[B]); X[B+1]=EX(X[B+1]); X[B+2]=EX(X[B+2]); X[B+3]=EX(X[B+3]); PIN(X); SBAR(); }while(0)
  #define VRD(i) do{ vlo[i]=vtr(vp_+(((i)>>2)*4096+((i)&3)*1024)); vhi[i]=vtr(vp_+(((i)>>2)*4096+((i)&3)*1024+512)); }while(0)
  #define KRD(G,j) do{ if(G){ kload2(kf,kp0+sl_next,j); SBAR(); } }while(0)
  #define STEP(C0,C1,P0,P1,t,GK,GV,GL) do{ SBAR(); \
    const lds_cptr vp_=vp0+2*sl_prev; \
    float sacc=(P0[0]+P0[1]); \
    GAPA(C0=__builtin_amdgcn_mfma_f32_32x32x16_bf16(kf[0],qr[0],negm,0,0,0), P0[2],P0[3],P0[4],P0[5],     pw0[0]=PKW(P0,0), pw0[1]=PKW(P0,2), pw0); \
    GAPA(C1=__builtin_amdgcn_mfma_f32_32x32x16_bf16(kf[1],qr[0],negm,0,0,0), P0[6],P0[7],P0[8],P0[9],     pw0[2]=PKW(P0,4), pw0[3]=PKW(P0,6), pw0); \
    GAPA(C0=__builtin_amdgcn_mfma_f32_32x32x16_bf16(kf[2],qr[1],C0,0,0,0),   P0[10],P0[11],P0[12],P0[13], pw1[0]=PKW(P0,8), pw1[1]=PKW(P0,10), pw1); \
    GAPA(C1=__builtin_amdgcn_mfma_f32_32x32x16_bf16(kf[3],qr[1],C1,0,0,0),   P0[14],P0[15],P1[0],P1[1],   pw1[2]=PKW(P0,12),pw1[3]=PKW(P0,14), pw1); \
    GAPA(C0=__builtin_amdgcn_mfma_f32_32x32x16_bf16(kf[4],qr[2],C0,0,0,0),   P1[2],P1[3],P1[4],P1[5],     pw2[0]=PKW(P1,0), pw2[1]=PKW(P1,2), pw2); \
    GAPA(C1=__builtin_amdgcn_mfma_f32_32x32x16_bf16(kf[5],qr[2],C1,0,0,0),   P1[6],P1[7],P1[8],P1[9],     pw2[2]=PKW(P1,4), pw2[3]=PKW(P1,6), pw2); \
    GAPA(C0=__builtin_amdgcn_mfma_f32_32x32x16_bf16(kf[6],qr[3],C0,0,0,0),   P1[10],P1[11],P1[12],P1[13], pw3[0]=PKW(P1,8), pw3[1]=PKW(P1,10), pw3); \
    VRDJ(0,0); VRDJ(1,0); SBAR(); \
    GAPA(C1=__builtin_amdgcn_mfma_f32_32x32x16_bf16(kf[7],qr[3],C1,0,0,0),   P1[14],P1[15],0.f,0.f,       pw3[2]=PKW(P1,12),pw3[3]=PKW(P1,14), pw3); \
    l_reg+=sacc; \
    VRDJ(2,0); VRDJ(3,0); SBAR(); \
    if(GK){DMA_K((t)+3,sl_cur);} if(GV){DMA_V((t)+1,sl_next);} \
    CMASK(C0,C1,t); \
    { float a=MX3(C0[0],C0[1],C1[0]),b=MX3(C0[2],C0[3],C1[1]); a=MX3(a,C1[2],C1[3]); \
      _Pragma("unroll") for(int r=4;r<16;r+=4){a=MX3(a,C0[r],C0[r+1]);b=MX3(b,C0[r+2],C0[r+3]);a=MX3(a,C1[r],C1[r+1]);b=MX3(b,C1[r+2],C1[r+3]);} \
      float rm=__builtin_fmaxf(a,b); { auto rr=__builtin_amdgcn_permlane32_swap(__float_as_uint(rm),__float_as_uint(rm),false,false); rm=__builtin_fmaxf(__uint_as_float(rr[0]),__uint_as_float(rr[1])); } \
      resc=false; \
      if(__builtin_expect(__any(rm>(float)THRL),0)){ const float dl=__builtin_fmaxf(rm,0.f); mhat+=dl; \
        _Pragma("unroll") for(int r=0;r<16;++r){C0[r]-=dl;C1[r]-=dl;} \
        _Pragma("unroll") for(int r=0;r<16;++r)negm[r]=-mhat; asm volatile("":"+v"(negm)); \
        const float f=__builtin_amdgcn_exp2f(-dl); l_reg*=f; if(hi==0)wsf[r32]=f; resc=true; } } \
    SBAR(); \
    GAPB2(PVM(0,0), C0,0);  VRDJ(0,1); SBAR(); \
    GAPB2(PVM(1,0), C0,2);  VRDJ(1,1); SBAR(); \
    GAPB2(PVM(2,0), C0,4);  VRDJ(2,1); SBAR(); \
    GAPB2(PVM(3,0), C0,6);  VRDJ(3,1); SBAR(); \
    KRD(GL,0); GAPB2(PVM(0,1), C0,8);  VRDJ(0,2); SBAR(); \
    KRD(GL,1); GAPB2(PVM(1,1), C0,10); VRDJ(1,2); SBAR(); \
    KRD(GL,2); GAPB2(PVM(2,1), C0,12); VRDJ(2,2); SBAR(); \
    KRD(GL,3); GAPB2(PVM(3,1), C0,14); VRDJ(3,2); SBAR(); \
    GAPB2(PVM(0,2), C1,0);  VRDJ(0,3); SBAR(); \
    GAPB2(PVM(1,2), C1,2);  VRDJ(1,3); SBAR(); \
    GAPB2(PVM(2,2), C1,4);  VRDJ(2,3); SBAR(); \
    GAPB2(PVM(3,2), C1,6);  VRDJ(3,3); SBAR(); \
    GAPB2(PVM(0,3), C1,8); \
    GAPB2(PVM(1,3), C1,10); \
    GAPB2(PVM(2,3), C1,12); \
    GAPB2(PVM(3,3), C1,14); \
    }while(0)
  int t=1;
  #undef CMASK
  #define CMASK(P0,P1,t) do{}while(0)
  for(;t+5<NT;t+=2){
    STEP(pB0,pB1,pA0,pA1,t,true,true,true);     WAIT_BAR(3); RESC(); ROT();
    STEP(pA0,pA1,pB0,pB1,t+1,true,true,true);   WAIT_BAR(3); RESC(); ROT();
  }
  #undef CMASK
  #define CMASK(P0,P1,t) do{int jb_=(t)-(NT-4); if(jb_>=0)cmask(P0,P1,jb_,qrel,hi);}while(0)
  #define ENDW(tt) do{ if((tt)+3<NT){WAIT_BAR(3);} else if((tt)+2<NT){WAIT_BAR(2);} else {WAIT_BAR(0);} }while(0)
  for(;t+1<NT;t+=2){
    STEP(pB0,pB1,pA0,pA1,t,(t+3<NT),(t+1<NT),(t+1<NT));       ENDW(t);   RESC(); ROT();
    STEP(pA0,pA1,pB0,pB1,t+1,(t+4<NT),(t+2<NT),(t+2<NT));     ENDW(t+1); RESC(); ROT();
  }
  STEP(pB0,pB1,pA0,pA1,NT-1,false,false,false); RESC();
  { float sacc=pB0[0]+pB0[1]; _Pragma("unroll") for(int r=2;r<16;++r)sacc+=pB0[r]; _Pragma("unroll") for(int r=0;r<16;++r)sacc+=pB1[r]; l_reg+=sacc;
    pw0=(u32x4){PKW(pB0,0),PKW(pB0,2),PKW(pB0,4),PKW(pB0,6)};pw1=(u32x4){PKW(pB0,8),PKW(pB0,10),PKW(pB0,12),PKW(pB0,14)};pw2=(u32x4){PKW(pB1,0),PKW(pB1,2),PKW(pB1,4),PKW(pB1,6)};pw3=(u32x4){PKW(pB1,8),PKW(pB1,10),PKW(pB1,12),PKW(pB1,14)};
    SBAR(); pv(o,vb0+2*sl_cur,PAF(0),PAF(1),PAF(2),PAF(3)); }
  #undef PKW
  #undef PAF
  #undef VFR
  #undef PIN
  #undef MX3
  #undef GAPA
  #undef GAPB
  #undef EX
  #undef VRD
  #undef VRDJ
  #undef GAPB2
  #undef PVM
  #undef KRD
  #undef STEP
  #undef ENDW
  {auto rr=__builtin_amdgcn_permlane32_swap(__float_as_uint(l_reg),__float_as_uint(l_reg),false,false);l_reg=__uint_as_float(rr[0])+__uint_as_float(rr[1]);}
  if(hi==0)wsf[32+r32]=l_reg;asm volatile("s_waitcnt lgkmcnt(0)":::"memory");
  float rli[16];
  #pragma unroll
  for(int r=0;r<16;++r)rli[r]=__builtin_amdgcn_rcpf(wsf[32+crow(r,hi)]);
  bf16*Ow=O+(rowbase+q0+wid*QBLK)*DM+vcol;
  { bf16*stg=(bf16*)(shm+LDS_OST)+wid*2048;
    #pragma unroll
    for(int hf=0;hf<2;++hf){
      #pragma unroll
      for(int r=0;r<16;++r){const int orow=crow(r,hi);
        #pragma unroll
        for(int d0=0;d0<2;++d0)stg[orow*64+d0*32+r32]=__float2bfloat16(o[2*hf+d0][r]*rli[r]);}
      asm volatile("s_waitcnt lgkmcnt(0)":::"memory");
      #pragma unroll
      for(int i=0;i<4;++i){const int row=i*8+(lane>>3),ch=lane&7; const u32x4 v=*(const u32x4*)(stg+row*64+ch*8); ATTN_STORE16(Ow+(long)row*DM+hf*64+ch*8,v);}
      asm volatile("s_waitcnt lgkmcnt(0)":::"memory"); } }
  asm volatile("s_waitcnt lgkmcnt(0)\n\ts_barrier":::"memory");
  #undef DMA_K
  #undef DMA_V
  #undef CMASK
  #undef START
  #undef RESC
  #undef ROT
}
constexpr int ATTN_LDS_BYTES=LDS_BYTES;
#undef SBAR
#undef WAIT_BAR
}
#define LAS __attribute__((address_space(3)))
typedef unsigned short bf16u;
typedef unsigned v4u __attribute__((ext_vector_type(4)));
typedef float f32x4 __attribute__((ext_vector_type(4)));
using pg8::pack8; using pg8::unpack8; using pg8::row_rstd;

#define XB_TMO      128
#define XB_XCNT(j)  (256  + 64 * (j))
#define XB_XSUB(j)  (1280 + 64 * (j))
#define XB_XGEN(j)  (2304 + 64 * (j))
#define XB_TOP      3328
#define XB_TOPGEN   3392
#define XCD_BAR_WORDS 3456
#define XB_SPIN_CAP (1u << 18)

__device__ __forceinline__ unsigned xb_ld(unsigned* p)              { return __hip_atomic_load(p, __ATOMIC_RELAXED, __HIP_MEMORY_SCOPE_AGENT); }
__device__ __forceinline__ unsigned xb_add(unsigned* p, unsigned v) { return __hip_atomic_fetch_add(p, v, __ATOMIC_RELAXED, __HIP_MEMORY_SCOPE_AGENT); }
__device__ __forceinline__ unsigned xb_xcc_id() { return (unsigned)__builtin_amdgcn_s_getreg((3 << 11) | 20) & 0xFu; }
#define XB_SPIN(cond, bar) do { unsigned _sp = 0; while (cond) { __builtin_amdgcn_s_sleep(1); \
    if ((++_sp & 255u) == 0u) { if (xb_ld(&(bar)[XB_TMO])) break; if (_sp > XB_SPIN_CAP) { atomicAdd(&(bar)[XB_TMO], 1u); break; } } } } while (0)

struct XcdBarrier {
    unsigned* bar; unsigned x;
    volatile LAS unsigned* st;
};

__device__ __forceinline__ XcdBarrier xcd_barrier_post(unsigned* bar, volatile LAS unsigned* st) {
    XcdBarrier b; b.bar = bar; b.x = xb_xcc_id(); b.st = st;
    if (threadIdx.x == 0) (void)xb_add(&bar[XB_XCNT(b.x)], 1u);
    return b;
}
__device__ __forceinline__ void xcd_barrier_complete(unsigned* bar, unsigned x, unsigned& nloc, unsigned& nx) {
    const unsigned G = gridDim.x * gridDim.y * gridDim.z;
    unsigned sum, cnt, mine, sp = 0u;
    for (;;) {
        sum = 0u; cnt = 0u; mine = 0u;
#pragma unroll
        for (unsigned j = 0; j < 16; ++j) { const unsigned c = xb_ld(&bar[XB_XCNT(j)]); sum += c; cnt += (c > 0u) ? 1u : 0u; mine = (j == x) ? c : mine; }
        if (sum == G) break;
        __builtin_amdgcn_s_sleep(1);
        if ((++sp & 255u) == 0u) { if (xb_ld(&bar[XB_TMO])) break; if (sp > XB_SPIN_CAP) { atomicAdd(&bar[XB_TMO], 1u); break; } }
    }
    nloc = mine > 0u ? mine : 1u; nx = cnt > 0u ? cnt : 1u;
}

__device__ __forceinline__ void xcd_barrier(const XcdBarrier& b) {
    asm volatile("s_waitcnt vmcnt(0)" ::: "memory");
    __syncthreads();
    if (threadIdx.x == 0) {
        unsigned* bar = b.bar;
        __builtin_amdgcn_s_waitcnt(0);
        unsigned nloc = b.st[0], nx = b.st[1];
        if (nloc == 0u) { xcd_barrier_complete(bar, b.x, nloc, nx); b.st[0] = nloc; b.st[1] = nx; }
        const unsigned old = xb_add(&bar[XB_XSUB(b.x)], 1u);
        const unsigned gen = old / nloc;
        if (old + 1u == (gen + 1u) * nloc) {
            __builtin_amdgcn_fence(__ATOMIC_RELEASE, "agent");
            asm volatile("s_waitcnt vmcnt(0)" ::: "memory");
            const unsigned og = xb_add(&bar[XB_TOP], 1u);
            const unsigned tg = og / nx;
            if (og + 1u == (tg + 1u) * nx) xb_add(&bar[XB_TOPGEN], 1u);
            else XB_SPIN(xb_ld(&bar[XB_TOPGEN]) == tg, bar);
            __builtin_amdgcn_fence(__ATOMIC_ACQUIRE, "agent");
            xb_add(&bar[XB_XGEN(b.x)], 1u);
            asm volatile("s_waitcnt vmcnt(0)" ::: "memory");
        } else {
            XB_SPIN(xb_ld(&bar[XB_XGEN(b.x)]) == gen, bar);
            __builtin_amdgcn_fence(__ATOMIC_ACQUIRE, "agent");
            asm volatile("s_waitcnt vmcnt(0)" ::: "memory");
        }
    }
    __syncthreads();
}


constexpr int NWAVES = 8;
constexpr int NTOK = 16384, DMOD = 1024, SEQL = 4096, NLAYER = 4, DFF = 2816, INW = 8192;
constexpr size_t MiB = 1u << 20;
constexpr size_t WS_ROPE = 0;
constexpr size_t WS_SSQA = 1 * MiB, WS_SSQB = 2 * MiB;
constexpr size_t WS_BAR = 3 * MiB + 65536, BAR_ZERO_BYTES = 65536;
constexpr size_t WS_LAM = 3 * MiB;
constexpr size_t WS_W = 4 * MiB, W_LAYER = 77 * MiB / 2;
constexpr size_t WL_IN = 0, WL_A = 16 * MiB, WL_B = 18 * MiB, WL_O = 20 * MiB, WL_GU = 22 * MiB, WL_D = 33 * MiB;
constexpr size_t WS_XB = 158 * MiB;
constexpr size_t BUFB = 32 * MiB, BUFE = BUFB / 2;
constexpr size_t WS_Q = 190 * MiB;
constexpr size_t WS_ACT = WS_Q;
constexpr size_t WS_STASH = WS_Q + 4 * BUFB;
constexpr size_t WS_O1 = 446 * MiB, WS_O2 = 478 * MiB;
constexpr size_t WS_END = 510 * MiB;
static_assert(WS_W + 4 * W_LAYER == WS_XB && (size_t)NTOK * DFF * 2 <= 3 * BUFB, "ws map");
constexpr int RING_BYTES = 131072, LDS_BYTES = 147456;

__device__ __forceinline__ float wave_sum(float v) {
#pragma unroll
    for (int o = 1; o < 64; o <<= 1) v += __shfl_xor(v, o);
    return v;
}
__device__ __forceinline__ unsigned f2bf(float f) { unsigned u = __builtin_bit_cast(unsigned, f); return (u + 0x7fffu + ((u >> 16) & 1u)) >> 16; }
__device__ __forceinline__ unsigned pk2(float lo, float hi) { return pg8::cvt_pk_bf16(lo, hi); }

template <int MODE>
__device__ __forceinline__ void p0_item(const float* W, int K, int N, bf16u* WT, const float* ks, LAS float* scr, int item, int lane) {
    const int nblk = N / 64, kb = item / nblk, nb = item - kb * nblk, k0 = 64 * kb, n0 = 64 * nb;
    int nn = n0 + lane;
    if (MODE == 1) {
        if (nn < 2048) { const int p = nn & 63; if (p < 16) nn = (nn & ~15) | (p & 3) | ((p & 4) << 1) | ((p & 8) >> 1); }
        else if (nn >= 4096) { const int sec = nn >= 6144 ? 6144 : 4096, r = nn - sec, q = r & 255; nn = sec + ((q >> 7) << 10) + 128 * (r >> 8) + (q & 127); }
    }
    int drow = n0;
    if (MODE == 2) drow = 256 * (n0 >> 7) + (n0 & 127);
    if (MODE == 3) drow = 256 * (n0 >> 7) + 128 + (n0 & 127);
    const float* src = W + (size_t)k0 * N + nn;
    float v[64];
#pragma unroll
    for (int kk = 0; kk < 64; ++kk) v[kk] = src[(size_t)kk * N];
    if (ks) {
#pragma unroll
        for (int kk = 0; kk < 64; ++kk) v[kk] *= ks[k0 + kk];
    }
#pragma unroll
    for (int kk = 0; kk < 64; ++kk) scr[kk * 65 + lane] = v[kk];
    asm volatile("s_waitcnt lgkmcnt(0)" ::: "memory");
    const int c = lane & 7;
#pragma unroll
    for (int j = 0; j < 8; ++j) { const int n = (lane >> 3) + 8 * j; const LAS float* s = scr + (8 * c) * 65 + n;
        v4u o; o.x = pk2(s[0 * 65], s[1 * 65]); o.y = pk2(s[2 * 65], s[3 * 65]); o.z = pk2(s[4 * 65], s[5 * 65]); o.w = pk2(s[6 * 65], s[7 * 65]);
        *(v4u*)(WT + (size_t)(drow + n) * K + k0 + 8 * c) = o; }
    asm volatile("s_waitcnt lgkmcnt(0)" ::: "memory");
}

__device__ __forceinline__ void conv_items(bf16u* BGb, const bf16u* CGb, const float* cw, int vcup, int G) {
    int tidp = threadIdx.x; asm volatile("" : "+v"(tidp));
    const int qd = tidp >> 7, c0 = (tidp & 127) * 8;
    float w0[8], w1[8], w2[8];
#pragma unroll
    for (int e = 0; e < 8; ++e) { w0[e] = cw[c0 + e]; w1[e] = cw[DMOD + c0 + e]; w2[e] = cw[2 * DMOD + c0 + e]; }
    for (int item = vcup * 4 + qd; item < NTOK / 16; item += G * 4) {
        const int r0 = item * 16;
        f32x4 p2a = (f32x4){0.f, 0.f, 0.f, 0.f}, p2b = p2a, p1a = p2a, p1b = p2a;
        if ((r0 & (SEQL - 1)) != 0) {
            unpack8(*(const v4u*)(CGb + (size_t)(r0 - 2) * DMOD + c0), p2a, p2b);
            unpack8(*(const v4u*)(CGb + (size_t)(r0 - 1) * DMOD + c0), p1a, p1b);
        }
#pragma unroll 8
        for (int i = 0; i < 16; ++i) {
            const size_t off = (size_t)(r0 + i) * DMOD + c0;
            f32x4 p0a, p0b, ba, bb;
            unpack8(*(const v4u*)(CGb + off), p0a, p0b); unpack8(*(const v4u*)(BGb + off), ba, bb);
            f32x4 ya, yb;
#pragma unroll
            for (int e = 0; e < 4; ++e) { ya[e] = ba[e] * (w0[e] * p2a[e] + w1[e] * p1a[e] + w2[e] * p0a[e]); yb[e] = bb[e] * (w0[4 + e] * p2b[e] + w1[4 + e] * p1b[e] + w2[4 + e] * p0b[e]); }
            *(v4u*)(BGb + off) = pack8(ya, yb);
            p2a = p1a; p2b = p1b; p1a = p0a; p1b = p0b;
        }
    }
}

constexpr int I_IN = (DMOD / 64) * (INW / 64), I_SQ = (DMOD / 64) * (DMOD / 64), I_G = (DMOD / 64) * (DFF / 64), I_D = (DFF / 64) * (DMOD / 64);
constexpr int I_LAYER = I_IN + 3 * I_SQ + 2 * I_G + I_D;
#define CONVERT_LAYER(LYR, START, STRIDE, LANE) do { \
        LAS float* scr_ = (LAS float*)(L + wave * 17408); const int l_ = (LYR); unsigned char* wl_ = ws + WS_W + (size_t)l_ * W_LAYER; \
        for (int it_ = (START); it_ < I_LAYER; it_ += (STRIDE)) { int r_ = it_; \
            if (r_ < I_IN) { p0_item<1>(w_in + (size_t)l_ * DMOD * INW, DMOD, INW, (bf16u*)(wl_ + WL_IN), mix_norm + l_ * DMOD, scr_, r_, LANE); continue; } r_ -= I_IN; \
            if (r_ < I_SQ) { p0_item<0>(w_a + (size_t)l_ * DMOD * DMOD, DMOD, DMOD, (bf16u*)(wl_ + WL_A), nullptr, scr_, r_, LANE); continue; } r_ -= I_SQ; \
            if (r_ < I_SQ) { p0_item<0>(w_b + (size_t)l_ * DMOD * DMOD, DMOD, DMOD, (bf16u*)(wl_ + WL_B), nullptr, scr_, r_, LANE); continue; } r_ -= I_SQ; \
            if (r_ < I_SQ) { p0_item<0>(w_o + (size_t)l_ * DMOD * DMOD, DMOD, DMOD, (bf16u*)(wl_ + WL_O), nullptr, scr_, r_, LANE); continue; } r_ -= I_SQ; \
            if (r_ < I_G) { p0_item<2>(w_gate + (size_t)l_ * DMOD * DFF, DMOD, DFF, (bf16u*)(wl_ + WL_GU), ffn_norm + l_ * DMOD, scr_, r_, LANE); continue; } r_ -= I_G; \
            if (r_ < I_G) { p0_item<3>(w_up + (size_t)l_ * DMOD * DFF, DMOD, DFF, (bf16u*)(wl_ + WL_GU), ffn_norm + l_ * DMOD, scr_, r_, LANE); continue; } r_ -= I_G; \
            p0_item<0>(w_down + (size_t)l_ * DFF * DMOD, DFF, DMOD, (bf16u*)(wl_ + WL_D), nullptr, scr_, r_, LANE); \
        } } while (0)

#define REP_SYNC 1
#define REP_P0 1
#define REP_P1 1
#define REP_P3 1
#define REP_P5 1
#define GSYNC() do { for (int r_ = 0; r_ < REP_SYNC; ++r_) xcd_barrier(bar); } while (0)
struct Args { const void* in[18]; float* out; unsigned char* ws; float linit[4]; float freq[8]; };

__global__ void __launch_bounds__(NWAVES * 64, 2) mk_fwd(Args a) {
    extern __shared__ __attribute__((aligned(16))) unsigned char lds[];
    cg::grid_group grid = cg::this_grid();
    LAS unsigned char* L = (LAS unsigned char*)lds;
    const int tid = threadIdx.x, lane = tid & 63, wave = __builtin_amdgcn_readfirstlane(tid >> 6);
    const int G = gridDim.x, bx = blockIdx.x;
    const int vcu = (G % 8 == 0) ? (bx % 8) * (G / 8) + bx / 8 : bx;
    unsigned char* ws = a.ws;
    const float* x_in = (const float*)a.in[0]; const int* positions = (const int*)a.in[1];
    const float* mix_norm = (const float*)a.in[2]; const float* w_in = (const float*)a.in[3];
    const float* lq1 = (const float*)a.in[4]; const float* lk1 = (const float*)a.in[5]; const float* lq2 = (const float*)a.in[6]; const float* lk2 = (const float*)a.in[7];
    const float* subln_w = (const float*)a.in[8]; const float* conv_w = (const float*)a.in[9];
    const float* w_a = (const float*)a.in[10]; const float* w_b = (const float*)a.in[11]; const float* w_o = (const float*)a.in[12];
    const float* ffn_norm = (const float*)a.in[13]; const float* w_gate = (const float*)a.in[14]; const float* w_up = (const float*)a.in[15]; const float* w_down = (const float*)a.in[16];
    const float* final_norm = (const float*)a.in[17];
    float* out = a.out;
    float* rope = (float*)(ws + WS_ROPE); float* ssqA = (float*)(ws + WS_SSQA); float* ssqB = (float*)(ws + WS_SSQB); float* lamtab = (float*)(ws + WS_LAM);
    bf16u* XB = (bf16u*)(ws + WS_XB);
    bf16u* Qb = (bf16u*)(ws + WS_Q); bf16u* Kb = Qb + BUFE; bf16u* Vb = Qb + 2 * BUFE; bf16u* BGb = Qb + 3 * BUFE; bf16u* CGb = Qb + 4 * BUFE; bf16u* Ub = Qb + 5 * BUFE;
    bf16u* SGA = Qb + 6 * BUFE; bf16u* SGB = Qb + 7 * BUFE;
    bf16u* ACT = (bf16u*)(ws + WS_ACT); float* STASH = (float*)(ws + WS_STASH);
    bf16u* O1 = (bf16u*)(ws + WS_O1); bf16u* O2 = (bf16u*)(ws + WS_O2); bf16u* MIXED = O1;
    const int gw = vcu * NWAVES + wave, NGW = G * NWAVES;
    volatile LAS unsigned* MISC = (volatile LAS unsigned*)(L + LDS_BYTES - 64);
    if (tid < 2) MISC[tid] = 0u;
    __syncthreads();
    const XcdBarrier bar = xcd_barrier_post((unsigned*)(ws + WS_BAR), MISC);

#pragma unroll 1
    for (int rep0 = 0; rep0 < REP_P0; ++rep0) {
        CONVERT_LAYER(0, gw, NGW, lane);
        for (int idx = (vcu * NWAVES * 64) + tid; idx < NTOK * 8; idx += G * NWAVES * 64) {
            const int row = idx >> 3, j = idx & 7;
            const float ang = (float)positions[row] * a.freq[j];
            rope[(size_t)row * 16 + j] = cosf(ang); rope[(size_t)row * 16 + 8 + j] = sinf(ang);
        }
        for (int m = gw; m < NTOK; m += NGW) {
            const f32x4* xr = (const f32x4*)(x_in + (size_t)m * DMOD) + lane;
            f32x4 v[4]; float s = 0.f;
#pragma unroll
            for (int j = 0; j < 4; ++j) { v[j] = xr[64 * j]; s += (v[j].x * v[j].x + v[j].y * v[j].y) + (v[j].z * v[j].z + v[j].w * v[j].w); }
            s = wave_sum(s);
            unsigned long long* o8 = (unsigned long long*)(XB + (size_t)m * DMOD) + lane;
#pragma unroll
            for (int j = 0; j < 4; ++j) o8[64 * j] = (unsigned long long)pk2(v[j].x, v[j].y) | ((unsigned long long)pk2(v[j].z, v[j].w) << 32);
            if (lane < 16) ssqA[(size_t)m * 16 + lane] = (lane == 0) ? s : 0.f;
        }
        if (vcu == 0 && wave == 0) {
            for (int l = 0; l < NLAYER; ++l) {
                const float s1 = wave_sum(lq1[l * 64 + lane] * lk1[l * 64 + lane]), s2 = wave_sum(lq2[l * 64 + lane] * lk2[l * 64 + lane]);
                if (lane == 0) lamtab[l] = expf(s1) - expf(s2) + a.linit[l];
            }
        }
    }
    if (a.ws == nullptr) grid.sync();
    GSYNC();

#pragma unroll 1
    for (int l = 0; l < NLAYER; ++l) {
        unsigned char* wl = ws + WS_W + (size_t)l * W_LAYER;
#pragma unroll 1
        for (int rep1 = 0; rep1 < REP_P1; ++rep1) {
            pg8::Gemm g{XB, (const bf16u*)(wl + WL_IN), NTOK, INW, DMOD}; int bxp = bx; asm volatile("" : "+s"(bxp)); pg8::StaticOrder S; S.init(NTOK, INW, G, bxp);
            pg8::Unit u0; int pm0 = -1; if (S.next(0, u0)) pm0 = u0.pm;
            { int tt_ = threadIdx.x; asm volatile("" : "+v"(tt_)); if (pm0 >= 0 && tt_ < 256) ((LAS float*)(L + RING_BYTES))[tt_] = pg8::row_rstd(ssqA, pm0 * 256 + tt_); }
            __syncthreads();
            pg8::EpiProj E{Qb, BUFE, ssqA, rope, attn_body::C2, pm0, (const LAS float*)(L + RING_BYTES)};
            pg8::gemm_phase<pg8::EpiProj, pg8::StaticOrder, true, true>(L, g, S, E);
        }
        GSYNC();
        {
            int vcup = vcu; asm volatile("" : "+s"(vcup));
            const float lam = lamtab[l], osc = 1.0f - a.linit[l];
            const float* sw = subln_w + l * 128;
            const int convslot = (G == 256) ? (vcup & 3) : 0; int ucount = 0; bool conv_done = false;
#pragma unroll 1
            for (int gidx = vcup; gidx < 512; gidx += G) {
                const int gi = gidx >> 8, v = gidx & 255, bh = v >> 3, s = v & 7, qb = gi ? 15 - s : s, b = bh >> 3, h = bh & 7;
#pragma unroll 1
                for (int m = 0; m < 2; ++m) {
                    if (ucount == convslot) { conv_items(BGb, CGb, conv_w + (size_t)l * 3 * DMOD, vcup, G); conv_done = true; }
                    ++ucount;
                    attn_body::attn_unit<8>(b, 2 * h + m, 128 * h, qb, (const attn_body::bf16*)Qb, (const attn_body::bf16*)Kb, (const attn_body::bf16*)Vb, (attn_body::bf16*)(m ? O2 : O1), (char*)lds);
                }
                asm volatile("s_waitcnt vmcnt(0)" ::: "memory");
                int tl_ = threadIdx.x; asm volatile("" : "+v"(tl_)); const int ln = tl_ & 63;
                const int c8 = (ln & 15) * 8;
                const f32x4 sw0 = *(const f32x4*)(sw + c8), sw1 = *(const f32x4*)(sw + c8 + 4);
                const size_t R0 = (size_t)b * SEQL + 256 * qb + 32 * wave;
#pragma unroll 2
                for (int it = 0; it < 8; ++it) {
                    const size_t off = (R0 + 4 * it + (ln >> 4)) * DMOD + 128 * h + c8;
                    f32x4 a0, a1, b0, b1; unpack8(*(const v4u*)(O1 + off), a0, a1); unpack8(*(const v4u*)(O2 + off), b0, b1);
                    const f32x4 d0 = a0 - b0 * lam, d1 = a1 - b1 * lam;
                    float ss = (d0[0] * d0[0] + d0[1] * d0[1]) + (d0[2] * d0[2] + d0[3] * d0[3]) + (d1[0] * d1[0] + d1[1] * d1[1]) + (d1[2] * d1[2] + d1[3] * d1[3]);
                    ss += pg8::shfl_xor_l(ss, 1, ln); ss += pg8::shfl_xor_l(ss, 2, ln); ss += pg8::shfl_xor_l(ss, 4, ln); ss += pg8::shfl_xor_l(ss, 8, ln);
                    const float rs = osc * __builtin_amdgcn_rsqf(ss * (1.0f / 128.0f) + 1e-6f);
                    *(v4u*)(Qb + off) = pack8(d0 * rs * sw0, d1 * rs * sw1);
                }
            }
            if (!conv_done) conv_items(BGb, CGb, conv_w + (size_t)l * 3 * DMOD, vcup, G);
        }
        GSYNC();
#pragma unroll 1
        for (int rep3 = 0; rep3 < REP_P3; ++rep3) {
            int bxp = bx; asm volatile("" : "+s"(bxp)); pg8::StaticOrder S; S.init(NTOK, DMOD, G, bxp);
            pg8::Gemm g{Qb, (const bf16u*)(wl + WL_A), NTOK, DMOD, DMOD, BGb, (const bf16u*)(wl + WL_B)}; pg8::EpiMix2 E{SGA, SGB, MIXED};
            pg8::gemm_phase<pg8::EpiMix2, pg8::StaticOrder, true, true, true>(L, g, S, E);
        }
        GSYNC();
        {
            pg8::Gemm g{MIXED, (const bf16u*)(wl + WL_O), NTOK, DMOD, DMOD}; int bxp = bx; asm volatile("" : "+s"(bxp)); pg8::StaticOrder S; S.init(NTOK, DMOD, G, bxp);
            pg8::EpiResid E{XB, ssqB};
            pg8::gemm_phase<pg8::EpiResid, pg8::StaticOrder, true, true>(L, g, S, E);
        }
        GSYNC();
#pragma unroll 1
        for (int rep5 = 0; rep5 < REP_P5; ++rep5) {
            pg8::Gemm g{XB, (const bf16u*)(wl + WL_GU), NTOK, 2 * DFF, DMOD}; int bxp = bx; asm volatile("" : "+s"(bxp)); pg8::StaticOrder S; S.init(NTOK, 2 * DFF, G, bxp);
            pg8::Unit u0; int pm0 = -1; if (S.next(0, u0)) pm0 = u0.pm;
            { int tt_ = threadIdx.x; asm volatile("" : "+v"(tt_)); if (pm0 >= 0 && tt_ < 256) ((LAS float*)(L + RING_BYTES))[tt_] = pg8::row_rstd(ssqB, pm0 * 256 + tt_); }
            __syncthreads();
            pg8::EpiSwiGLU E{ACT, DFF, ssqB, pm0, (const LAS float*)(L + RING_BYTES)};
            pg8::gemm_phase<pg8::EpiSwiGLU, pg8::StaticOrder, true, true>(L, g, S, E);
            if (l + 1 < NLAYER && rep5 == 0) {
                const int nwg5 = (NTOK / 256) * (2 * DFF / 256), rem = nwg5 % G;
                const bool light = (rem == 0) || (bxp >= rem);
                if (light) { int tc_ = threadIdx.x; asm volatile("" : "+v"(tc_)); const int lnc = tc_ & 63; const int nl = (rem == 0) ? G : G - rem, li = (rem == 0) ? bxp : bxp - rem;
                    CONVERT_LAYER(l + 1, li * NWAVES + wave, nl * NWAVES, lnc); }
            }
        }
        GSYNC();
        {
            pg8::Gemm g{ACT, (const bf16u*)(wl + WL_D), NTOK, DMOD, DFF}; int bxp = bx; asm volatile("" : "+s"(bxp)); pg8::StaticOrder S; S.init(NTOK, DMOD, G, bxp);
            pg8::EpiResid E{XB, ssqA};
            pg8::gemm_phase<pg8::EpiResid, pg8::StaticOrder, true, true>(L, g, S, E);
        }
        GSYNC();
    }
    int tf_ = threadIdx.x; asm volatile("" : "+v"(tf_)); const int lnf = tf_ & 63;
    for (int m = gw; m < NTOK; m += NGW) {
        const float rstd = row_rstd(ssqA, m);
#pragma unroll
        for (int j = 0; j < 2; ++j) {
            const int c = 8 * lnf + 512 * j;
            f32x4 x0, x1; unpack8(*(const v4u*)(XB + (size_t)m * DMOD + c), x0, x1);
            const f32x4 w0 = *(const f32x4*)(final_norm + c), w1 = *(const f32x4*)(final_norm + c + 4);
            *(f32x4*)(out + (size_t)m * DMOD + c) = x0 * rstd * w0; *(f32x4*)(out + (size_t)m * DMOD + c + 4) = x1 * rstd * w1;
        }
    }
}

extern "C" void kernel_launch(void* const* d_in, const int* in_sizes, int n_in, void* d_out, int out_size, void* d_ws, size_t ws_size, hipStream_t stream) {
    static int grid = 0;
    if (grid == 0) {
        if (n_in != 18 || out_size != NTOK * DMOD || ws_size < WS_END) { fprintf(stderr, "kernel_launch: unexpected shapes (n_in %d, out %d, ws %zu)\n", n_in, out_size, ws_size); grid = -1; return; }
        int dev = 0, cus = 0, per_cu = 0;
        if (hipGetDevice(&dev) != hipSuccess || hipDeviceGetAttribute(&cus, hipDeviceAttributeMultiprocessorCount, dev) != hipSuccess) { grid = -1; return; }
        if (hipFuncSetAttribute((const void*)mk_fwd, hipFuncAttributeMaxDynamicSharedMemorySize, LDS_BYTES) != hipSuccess) { fprintf(stderr, "kernel_launch: hipFuncSetAttribute failed\n"); grid = -1; return; }
        if (hipOccupancyMaxActiveBlocksPerMultiprocessor(&per_cu, (const void*)mk_fwd, NWAVES * 64, LDS_BYTES) != hipSuccess || per_cu < 1) per_cu = 1;
        (void)hipGetLastError();
        grid = cus * per_cu;
    }
    if (grid < 0) return;
    if (hipMemsetAsync((unsigned char*)d_ws + WS_BAR, 0, BAR_ZERO_BYTES, stream) != hipSuccess) { fprintf(stderr, "kernel_launch: memset failed\n"); return; }
    Args a{};
    for (int i = 0; i < 18; ++i) a.in[i] = d_in[i];
    a.out = (float*)d_out; a.ws = (unsigned char*)d_ws;
    for (int l = 0; l < 4; ++l) a.linit[l] = (float)(0.8 - 0.6 * exp(-0.3 * (double)l));
    for (int j = 0; j < 8; ++j) a.freq[j] = (float)pow(500000.0, -(double)j / 8.0);
    void* args[] = {&a};
    hipError_t e = hipLaunchCooperativeKernel((const void*)mk_fwd, dim3(grid), dim3(NWAVES * 64), args, LDS_BYTES, stream);
    if (e != hipSuccess) fprintf(stderr, "kernel_launch: cooperative launch failed: %s (grid %d)\n", hipGetErrorString(e), grid);
}
```

```cpp
#include <hip/hip_runtime.h>
#include <hip/hip_cooperative_groups.h>
#include <cstdio>
#include <cstdint>
namespace cg = cooperative_groups;
namespace pg8 {
#define PG8_LAS __attribute__((address_space(3)))
typedef unsigned short bf16_t;
typedef short bf16x8 __attribute__((ext_vector_type(8)));
typedef float f32x4 __attribute__((ext_vector_type(4)));
typedef unsigned u32x4 __attribute__((ext_vector_type(4)));
constexpr int BM = 256, BK = 64, HALF = 128, HTB = HALF * BK * 2  , STAGE_BYTES = 8 * HTB, NXCD = 8, WGM = 8;

__host__ __device__ __forceinline__ int lds_byte(int r, int c) { const int st = (r >> 4) * 2 + (c >> 5), rr = r & 15, cc = c & 31, ob = rr * 64 + cc * 2; return st * 1024 + (ob ^ (((ob >> 9) & 1) << 5)); }
__host__ __device__ __forceinline__ void stage_rc(int b, int& R, int& C) { const int st = b / 1024, sb = b % 1024, swz = sb ^ (((sb >> 9) & 1) << 5); R = (st >> 1) * 16 + swz / 64; C = (st & 1) * 32 + (swz % 64) / 2; }
__host__ __device__ __forceinline__ int perm32(int rho) { const int n = rho >> 4, i = rho & 15; return 8 * (i >> 2) + 4 * n + (i & 3); }

struct Unit { int pm, pn; };
struct Gemm { const bf16_t* A; const bf16_t* Bt; int M, N, K; const bf16_t* A2 = nullptr; const bf16_t* Bt2 = nullptr; };

struct StaticOrder {
    int nM, nN, nwg, G, c;
    __host__ __device__ void init(int M, int N, int G_, int c_) { nM = M / BM; nN = N / BM; nwg = nM * nN; G = G_; c = c_; }
    __host__ __device__ bool next(int i, Unit& u) const {
        const long L = (long)i * G + c; if (L >= nwg) return false;
        int wgid = (int)L; { const int q = nwg / NXCD, r = nwg % NXCD, xcd = wgid % NXCD, off = wgid / NXCD; wgid = (xcd < r ? xcd * (q + 1) : r * (q + 1) + (xcd - r) * q) + off; }
        const int nig = WGM * nN, gid = wgid / nig, fm = gid * WGM, gsz = (nM - fm) < WGM ? (nM - fm) : WGM;
        u.pm = fm + ((wgid % nig) % gsz); u.pn = (wgid % nig) / gsz; return true;
    }
    __device__ __forceinline__ void a_ready(const Unit&) const {}
    __device__ __forceinline__ void done(const Unit&) const {}
};

typedef float f32x2cv __attribute__((ext_vector_type(2))); typedef __bf16 bf16x2cv __attribute__((ext_vector_type(2)));
__device__ __forceinline__ unsigned cvt_pk_bf16(float lo, float hi) { const f32x2cv v = {lo, hi}; return __builtin_bit_cast(unsigned, __builtin_convertvector(v, bf16x2cv)); }
typedef float f32x2 __attribute__((ext_vector_type(2)));
typedef unsigned u32x2 __attribute__((ext_vector_type(2)));
__device__ __forceinline__ u32x4 pack8(const f32x4 v0, const f32x4 v1) { u32x4 w; w.x = cvt_pk_bf16(v0[0], v0[1]); w.y = cvt_pk_bf16(v0[2], v0[3]); w.z = cvt_pk_bf16(v1[0], v1[1]); w.w = cvt_pk_bf16(v1[2], v1[3]); return w; }
__device__ __forceinline__ float bf_lo(unsigned w) { return __uint_as_float(w << 16); }
__device__ __forceinline__ float bf_hi(unsigned w) { return __uint_as_float(w & 0xffff0000u); }
__device__ __forceinline__ void unpack8(const u32x4 w, f32x4& v0, f32x4& v1) { v0 = (f32x4){bf_lo(w.x), bf_hi(w.x), bf_lo(w.y), bf_hi(w.y)}; v1 = (f32x4){bf_lo(w.z), bf_hi(w.z), bf_lo(w.w), bf_hi(w.w)}; }
__device__ __forceinline__ float row_rstd(const float* ssq, int row) {
    const f32x4* p = (const f32x4*)(ssq + (size_t)row * 16);
    const f32x4 s = (p[0] + p[1]) + (p[2] + p[3]);
    return __builtin_amdgcn_rsqf(((s[0] + s[1]) + (s[2] + s[3])) * (1.0f / 1024.0f) + 1e-6f);
}
__device__ __forceinline__ float shfl_xor_l(float v, int mask, int lane) { return __builtin_bit_cast(float, __builtin_amdgcn_ds_bpermute((lane ^ mask) << 2, __builtin_bit_cast(int, v))); }
__device__ __forceinline__ float sigm(float v) { return __builtin_amdgcn_rcpf(1.0f + __expf(-v)); }

struct EpiProj {
    static constexpr bool PERM = true, AFTER_DRAIN = false;
    bf16_t* base; size_t stride; const float* ssq; const float* rope; float qscale; int pm0; const PG8_LAS float* rtab;
    __device__ __forceinline__ void operator()(const f32x4 (&acc)[2][2][4][2], const Unit& u, int wr, int wc, int fr_in, int fq_in) const {
        int fr = fr_in, fq = fq_in; asm volatile("" : "+v"(fr), "+v"(fq));
        const int colt = u.pn * BM, sec = colt >> 11, row0 = u.pm * BM + wr * 64 + fr;
        float rstd[2][4];
        if (u.pm == pm0) {
#pragma unroll
            for (int ai = 0; ai < 2; ++ai)
#pragma unroll
                for (int m = 0; m < 4; ++m) rstd[ai][m] = rtab[ai * HALF + wr * 64 + m * 16 + fr];
        } else {
#pragma unroll
            for (int ai = 0; ai < 2; ++ai)
#pragma unroll
                for (int m = 0; m < 4; ++m) rstd[ai][m] = row_rstd(ssq, row0 + ai * HALF + m * 16);
        }
        if (sec == 0) {
            const int t = colt >> 10;
            bf16_t* O = base + (size_t)t * stride + (colt & 1023) + wc * 32 + 8 * fq;
            const bool dorope = ((wc & 1) == 0) && (fq < 2);
            const int rofs = dorope ? 4 * fq : 0;
            const float sc = (t == 0) ? qscale : 1.0f;
#pragma unroll
            for (int ai = 0; ai < 2; ++ai) {
                f32x4 c4[4], s4[4];
#pragma unroll
                for (int m = 0; m < 4; ++m) { const float* rp = rope + (size_t)(row0 + ai * HALF + m * 16) * 16 + rofs; c4[m] = *(const f32x4*)rp; s4[m] = *(const f32x4*)(rp + 8); }
#pragma unroll
                for (int m = 0; m < 4; ++m) {
                    const f32x4 cc = dorope ? c4[m] : (f32x4){1.f, 1.f, 1.f, 1.f}, ss = dorope ? s4[m] : (f32x4){0.f, 0.f, 0.f, 0.f};
                    const float rs = rstd[ai][m] * sc;
                    bf16_t* rowp = O + (size_t)(row0 + ai * HALF + m * 16) * 1024;
#pragma unroll
                    for (int bj = 0; bj < 2; ++bj) {
                        const f32x4 v0 = acc[ai][bj][m][0] * rs, v1 = acc[ai][bj][m][1] * rs;
                        *(u32x4*)(rowp + bj * HALF) = pack8(v0 * cc - v1 * ss, v1 * cc + v0 * ss);
                    }
                }
            }
        } else if (sec == 1) {
            const int t = colt >> 10;
            bf16_t* O = base + (size_t)t * stride + (colt & 1023) + wc * 32 + 8 * fq;
#pragma unroll
            for (int ai = 0; ai < 2; ++ai)
#pragma unroll
                for (int m = 0; m < 4; ++m) {
                    bf16_t* rowp = O + (size_t)(row0 + ai * HALF + m * 16) * 1024;
#pragma unroll
                    for (int bj = 0; bj < 2; ++bj) *(u32x4*)(rowp + bj * HALF) = pack8(acc[ai][bj][m][0] * rstd[ai][m], acc[ai][bj][m][1] * rstd[ai][m]);
                }
        } else {
            const int cb = ((colt & 2047) >> 8) * 128 + wc * 32 + 8 * fq;
            if (sec == 2) {
#pragma unroll
                for (int ai = 0; ai < 2; ++ai)
#pragma unroll
                    for (int m = 0; m < 4; ++m) {
                        const float r2 = rstd[ai][m] * rstd[ai][m];
                        *(u32x4*)(base + 4 * stride + (size_t)(row0 + ai * HALF + m * 16) * 1024 + cb) = pack8(acc[ai][0][m][0] * acc[ai][1][m][0] * r2, acc[ai][0][m][1] * acc[ai][1][m][1] * r2);
                    }
            } else {
#pragma unroll
                for (int ai = 0; ai < 2; ++ai)
#pragma unroll
                    for (int m = 0; m < 4; ++m) {
                        const size_t off = (size_t)(row0 + ai * HALF + m * 16) * 1024 + cb;
                        f32x4 a0 = acc[ai][0][m][0] * rstd[ai][m], a1 = acc[ai][0][m][1] * rstd[ai][m], b0 = acc[ai][1][m][0] * rstd[ai][m], b1 = acc[ai][1][m][1] * rstd[ai][m];
#pragma unroll
                        for (int e = 0; e < 4; ++e) {
                            const float eb0 = 1.0f + __expf(-b0[e]), eb1 = 1.0f + __expf(-b1[e]);
                            a0[e] = eb0 * __builtin_amdgcn_rcpf(1.0f + __expf(-a0[e])); a1[e] = eb1 * __builtin_amdgcn_rcpf(1.0f + __expf(-a1[e]));
                            b0[e] = __builtin_amdgcn_rcpf(eb0); b1[e] = __builtin_amdgcn_rcpf(eb1); }
                        *(u32x4*)(base + 6 * stride + off) = pack8(a0, a1);
                        *(u32x4*)(base + 7 * stride + off) = pack8(b0, b1);
                    }
            }
        }
    }
};
struct EpiMix2 {
    static constexpr bool PERM = true, AFTER_DRAIN = false;
    const bf16_t* rat; const bf16_t* sgb; bf16_t* mixed;
    __device__ __forceinline__ void mid(f32x4 (&acc)[2][2][4][2], const Unit& u, int wr, int wc, int fr_in, int fq_in) const {
        int fr = fr_in, fq = fq_in; asm volatile("" : "+v"(fr), "+v"(fq));
        const bf16_t* gp = rat + (size_t)(u.pm * BM + wr * 64 + fr) * 1024 + u.pn * BM + wc * 32 + 8 * fq;
        u32x4 g[2][4][2];
#pragma unroll
        for (int ai = 0; ai < 2; ++ai)
#pragma unroll
            for (int m = 0; m < 4; ++m)
#pragma unroll
                for (int bj = 0; bj < 2; ++bj) g[ai][m][bj] = *(const u32x4*)(gp + (size_t)(ai * HALF + m * 16) * 1024 + bj * HALF);
#pragma unroll
        for (int ai = 0; ai < 2; ++ai)
#pragma unroll
            for (int m = 0; m < 4; ++m)
#pragma unroll
                for (int bj = 0; bj < 2; ++bj) { f32x4 g0, g1; unpack8(g[ai][m][bj], g0, g1); acc[ai][bj][m][0] = acc[ai][bj][m][0] * g0; acc[ai][bj][m][1] = acc[ai][bj][m][1] * g1; }
    }
    __device__ __forceinline__ void operator()(const f32x4 (&acc)[2][2][4][2], const Unit& u, int wr, int wc, int fr_in, int fq_in) const {
        int fr = fr_in, fq = fq_in; asm volatile("" : "+v"(fr), "+v"(fq));
        const size_t off0 = (size_t)(u.pm * BM + wr * 64 + fr) * 1024 + u.pn * BM + wc * 32 + 8 * fq;
        u32x4 g[2][4][2];
#pragma unroll
        for (int ai = 0; ai < 2; ++ai)
#pragma unroll
            for (int m = 0; m < 4; ++m)
#pragma unroll
                for (int bj = 0; bj < 2; ++bj) g[ai][m][bj] = *(const u32x4*)(sgb + off0 + (size_t)(ai * HALF + m * 16) * 1024 + bj * HALF);
#pragma unroll
        for (int ai = 0; ai < 2; ++ai)
#pragma unroll
            for (int m = 0; m < 4; ++m)
#pragma unroll
                for (int bj = 0; bj < 2; ++bj) { f32x4 g0, g1; unpack8(g[ai][m][bj], g0, g1);
                    *(u32x4*)(mixed + off0 + (size_t)(ai * HALF + m * 16) * 1024 + bj * HALF) = pack8(acc[ai][bj][m][0] * g0, acc[ai][bj][m][1] * g1); }
    }
};
struct EpiResid {
    static constexpr bool PERM = true, AFTER_DRAIN = false;
    bf16_t* xb; float* ssq;
    __device__ __forceinline__ void operator()(const f32x4 (&acc)[2][2][4][2], const Unit& u, int wr, int wc, int fr_in, int fq_in) const {
        int fr = fr_in, fq = fq_in; asm volatile("" : "+v"(fr), "+v"(fq));
        const int row0 = u.pm * BM + wr * 64 + fr, ln_ = fr + 16 * fq;
        bf16_t* xp = xb + (size_t)row0 * 1024 + u.pn * BM + wc * 32 + 8 * fq;
        u32x4 xv[2][4][2];
#pragma unroll
        for (int ai = 0; ai < 2; ++ai)
#pragma unroll
            for (int m = 0; m < 4; ++m)
#pragma unroll
                for (int bj = 0; bj < 2; ++bj) xv[ai][m][bj] = *(const u32x4*)(xp + (size_t)(ai * HALF + m * 16) * 1024 + bj * HALF);
#pragma unroll
        for (int ai = 0; ai < 2; ++ai)
#pragma unroll
            for (int m = 0; m < 4; ++m) {
                float ss = 0.f;
#pragma unroll
                for (int bj = 0; bj < 2; ++bj) {
                    f32x4 x0, x1; unpack8(xv[ai][m][bj], x0, x1);
                    const f32x4 v0 = x0 + acc[ai][bj][m][0], v1 = x1 + acc[ai][bj][m][1];
                    *(u32x4*)(xp + (size_t)(ai * HALF + m * 16) * 1024 + bj * HALF) = pack8(v0, v1);
                    ss += (v0[0] * v0[0] + v0[1] * v0[1]) + (v0[2] * v0[2] + v0[3] * v0[3]) + (v1[0] * v1[0] + v1[1] * v1[1]) + (v1[2] * v1[2] + v1[3] * v1[3]);
                }
                ss += shfl_xor_l(ss, 16, ln_); ss += shfl_xor_l(ss, 32, ln_);
                ssq[(size_t)(row0 + ai * HALF + m * 16) * 16 + u.pn * 4 + wc] = ss;
            }
    }
};
struct EpiSwiGLU {
    static constexpr bool PERM = true, AFTER_DRAIN = false;
    bf16_t* act; int ldc; const float* ssq; int pm0; const PG8_LAS float* rtab;
    __device__ __forceinline__ void operator()(const f32x4 (&acc)[2][2][4][2], const Unit& u, int wr, int wc, int fr_in, int fq_in) const {
        int fr = fr_in, fq = fq_in; asm volatile("" : "+v"(fr), "+v"(fq));
        const int row0 = u.pm * BM + wr * 64 + fr;
        float rstd[2][4];
        if (u.pm == pm0) {
#pragma unroll
            for (int ai = 0; ai < 2; ++ai)
#pragma unroll
                for (int m = 0; m < 4; ++m) rstd[ai][m] = rtab[ai * HALF + wr * 64 + m * 16 + fr];
        } else {
#pragma unroll
            for (int ai = 0; ai < 2; ++ai)
#pragma unroll
                for (int m = 0; m < 4; ++m) rstd[ai][m] = row_rstd(ssq, row0 + ai * HALF + m * 16);
        }
#pragma unroll
        for (int ai = 0; ai < 2; ++ai)
#pragma unroll
            for (int m = 0; m < 4; ++m) {
                f32x4 o[2];
#pragma unroll
                for (int n = 0; n < 2; ++n) {
                    const f32x4 g = acc[ai][0][m][n] * rstd[ai][m], up = acc[ai][1][m][n] * rstd[ai][m];
#pragma unroll
                    for (int e = 0; e < 4; ++e) o[n][e] = g[e] * sigm(g[e]) * up[e];
                }
                *(u32x4*)(act + (size_t)(row0 + ai * HALF + m * 16) * ldc + u.pn * HALF + wc * 32 + 8 * fq) = pack8(o[0], o[1]);
            }
    }
};
template <class Epi, class Sched, bool ALIGN_EPI = false, bool SP2 = false, bool SPLITK = false>
__device__ __forceinline__ void gemm_phase(PG8_LAS unsigned char* lds, const Gemm g, const Sched& S, const Epi& E) {
    int tid_l = threadIdx.x; asm volatile("" : "+v"(tid_l));
    const int tid = tid_l, wid = __builtin_amdgcn_readfirstlane(tid >> 6), lane = tid & 63, wr = wid >> 2, wc = wid & 3, fr = lane & 15, fq = lane >> 4;
    const int K = g.K, nt1 = K / BK, nt = SPLITK ? 2 * nt1 : nt1;
    unsigned voffA[2], voffB[2];
#pragma unroll
    for (int i = 0; i < 2; ++i) { int R, C; stage_rc(tid * 16 + i * 8192, R, C); const int Rb = Epi::PERM ? ((R & ~31) + perm32(R & 31)) : R;
        voffA[i] = (unsigned)(R * K + C) * 2u; voffB[i] = (unsigned)(Rb * K + C) * 2u; }
    const size_t kstep = (size_t)(BK * 2);
    const size_t hstep = (size_t)HALF * K * 2;
    const size_t tstep = 2 * hstep;
    const unsigned ldsw = (unsigned)wid * 1024u;
    const int aoff = lds_byte(wr * 64 + fr, fq * 8), boff = lds_byte(wc * 32 + fr, fq * 8);
#define PG8_SA(b, h) (((b) * 2 + (h)) * HTB)
#define PG8_SB(b, h) ((4 + (b) * 2 + (h)) * HTB)
#define PG8_STAGE(bufoff, gbase, voff) do { _Pragma("unroll") for (int _i = 0; _i < 2; ++_i) \
        __builtin_amdgcn_global_load_lds((const unsigned*)((const char*)(gbase) + (voff)[_i]), (PG8_LAS unsigned*)(lds + (bufoff) + ldsw + _i * 8192), 16, 0, 0); } while (0)
#define PG8_LDA(dst, b, h) do { _Pragma("unroll") for (int m = 0; m < 4; ++m) _Pragma("unroll") for (int k = 0; k < 2; ++k) dst[m][k] = *(const PG8_LAS bf16x8*)(lds + PG8_SA(b, h) + aoff + m * 2048 + k * 1024); } while (0)
#define PG8_LDB(dst, b, h) do { _Pragma("unroll") for (int n = 0; n < 2; ++n) _Pragma("unroll") for (int k = 0; k < 2; ++k) dst[n][k] = *(const PG8_LAS bf16x8*)(lds + PG8_SB(b, h) + boff + n * 2048 + k * 1024); } while (0)
#define PG8_MMA(ai, bj, At, Bt) do { __builtin_amdgcn_s_setprio(1); _Pragma("unroll") for (int m = 0; m < 4; ++m) _Pragma("unroll") for (int n = 0; n < 2; ++n) _Pragma("unroll") for (int k = 0; k < 2; ++k) \
        acc[ai][bj][m][n] = __builtin_amdgcn_mfma_f32_16x16x32_bf16(Bt[n][k], At[m][k], acc[ai][bj][m][n], 0, 0, 0); __builtin_amdgcn_s_setprio(0); } while (0)
#define PG8_WAIT_V(n) asm volatile("s_waitcnt vmcnt(" #n ")" ::: "memory")
#define PG8_WAIT_L(n) asm volatile("s_waitcnt lgkmcnt(" #n ")" ::: "memory")
#define PG8_BAR __builtin_amdgcn_s_barrier()
#define PG8_SCHED __builtin_amdgcn_sched_barrier(0)
    Unit cur, nxt; int ui = 0;
    if (!S.next(0, cur)) return;
    f32x4 acc[2][2][4][2];
#pragma unroll
    for (int a = 0; a < 2; ++a)
#pragma unroll
        for (int b = 0; b < 2; ++b)
#pragma unroll
            for (int m = 0; m < 4; ++m)
#pragma unroll
                for (int n = 0; n < 2; ++n) acc[a][b][m][n] = (f32x4){0.f, 0.f, 0.f, 0.f};
    bf16x8 At[4][2], B0[2][2], B1[2][2];
    const char* cA = (const char*)g.A + (size_t)cur.pm * tstep; const char* cB = (const char*)g.Bt + (size_t)cur.pn * tstep;
    const char* cA2 = SPLITK ? (const char*)g.A2 + (size_t)cur.pm * tstep : cA; const char* cB2 = SPLITK ? (const char*)g.Bt2 + (size_t)cur.pn * tstep : cB;
#define PG8_TA(tt) ((SPLITK && (tt) >= nt1) ? cA2 + (size_t)((tt) - nt1) * kstep : cA + (size_t)(tt) * kstep)
#define PG8_TB(tt) ((SPLITK && (tt) >= nt1) ? cB2 + (size_t)((tt) - nt1) * kstep : cB + (size_t)(tt) * kstep)
    S.a_ready(cur);
    if constexpr (SP2) {
        PG8_STAGE(PG8_SB(0, 0), cB, voffB); PG8_STAGE(PG8_SB(0, 1), cB + hstep, voffB); PG8_STAGE(PG8_SA(0, 0), cA, voffA); PG8_STAGE(PG8_SA(0, 1), cA + hstep, voffA);
        PG8_STAGE(PG8_SB(1, 0), cB + kstep, voffB); PG8_STAGE(PG8_SA(1, 0), cA + kstep, voffA); PG8_STAGE(PG8_SB(1, 1), cB + hstep + kstep, voffB);
        if (wr == 1) PG8_BAR;
        PG8_WAIT_V(8); PG8_BAR;
        PG8_WAIT_V(6); PG8_BAR;
    } else {
        PG8_STAGE(PG8_SB(0, 0), cB, voffB); PG8_STAGE(PG8_SA(0, 0), cA, voffA); PG8_STAGE(PG8_SB(0, 1), cB + hstep, voffB); PG8_STAGE(PG8_SA(0, 1), cA + hstep, voffA);
        if (wr == 1) PG8_BAR;
        PG8_WAIT_V(4); PG8_BAR;
        PG8_STAGE(PG8_SB(1, 0), cB + kstep, voffB); PG8_STAGE(PG8_SA(1, 0), cA + kstep, voffA); PG8_STAGE(PG8_SB(1, 1), cB + hstep + kstep, voffB);
        PG8_WAIT_V(6); PG8_BAR;
    }
    for (;;) {
        const bool has_next = S.next(ui + 1, nxt);
        const char* nA = has_next ? (const char*)g.A + (size_t)nxt.pm * tstep : cA; const char* nB = has_next ? (const char*)g.Bt + (size_t)nxt.pn * tstep : cB;
        for (int t = 0; t < nt; t += 2) {
            const bool last = (t == nt - 2);
            if constexpr (SPLITK) { if (t == nt1) E.mid(acc, cur, wr, wc, fr, fq); }
            const char* a1 = PG8_TA(t + 1);
            const char* a2 = last ? nA : PG8_TA(t + 2); const char* b2 = last ? nB : PG8_TB(t + 2);
            const char* a3 = a2 + kstep; const char* b3 = b2 + kstep;
            if (last && has_next) S.a_ready(nxt);
            if constexpr (SP2) {
            PG8_LDB(B0, 0, 0); PG8_LDB(B1, 0, 1); PG8_SCHED; PG8_LDA(At, 0, 0); PG8_STAGE(PG8_SA(1, 1), a1 + hstep, voffA);
            PG8_WAIT_V(8); PG8_WAIT_L(0); PG8_BAR; PG8_MMA(0, 0, At, B0); PG8_MMA(0, 1, At, B1); PG8_BAR; PG8_SCHED;
            PG8_LDA(At, 0, 1); PG8_STAGE(PG8_SB(0, 0), b2, voffB); PG8_STAGE(PG8_SB(0, 1), b2 + hstep, voffB); PG8_STAGE(PG8_SA(0, 0), a2, voffA);
            PG8_WAIT_V(8); PG8_WAIT_L(0); PG8_BAR; PG8_MMA(1, 0, At, B0); PG8_MMA(1, 1, At, B1); PG8_BAR; PG8_SCHED;
            PG8_LDB(B0, 1, 0); PG8_LDB(B1, 1, 1); PG8_SCHED; PG8_LDA(At, 1, 0); PG8_STAGE(PG8_SA(0, 1), a2 + hstep, voffA);
            PG8_WAIT_V(8); PG8_WAIT_L(0); PG8_BAR; PG8_MMA(0, 0, At, B0); PG8_MMA(0, 1, At, B1); PG8_BAR; PG8_SCHED;
            PG8_LDA(At, 1, 1); PG8_STAGE(PG8_SB(1, 0), b3, voffB); PG8_STAGE(PG8_SB(1, 1), b3 + hstep, voffB); PG8_STAGE(PG8_SA(1, 0), a3, voffA);
            PG8_WAIT_V(8); PG8_WAIT_L(0); PG8_BAR; PG8_MMA(1, 0, At, B0); PG8_MMA(1, 1, At, B1); PG8_BAR; PG8_SCHED;
            } else {
            PG8_LDB(B0, 0, 0); PG8_SCHED; PG8_LDA(At, 0, 0); PG8_STAGE(PG8_SA(1, 1), a1 + hstep, voffA);
            PG8_WAIT_L(8); PG8_BAR; PG8_WAIT_L(0); PG8_MMA(0, 0, At, B0); PG8_BAR; PG8_SCHED;
            PG8_LDB(B1, 0, 1); PG8_STAGE(PG8_SB(0, 0), b2, voffB);
            PG8_BAR; PG8_WAIT_L(0); PG8_MMA(0, 1, At, B1); PG8_BAR;
            PG8_LDA(At, 0, 1); PG8_STAGE(PG8_SA(0, 0), a2, voffA);
            PG8_BAR; PG8_WAIT_L(0); PG8_MMA(1, 0, At, B0); PG8_BAR; PG8_SCHED;
            PG8_STAGE(PG8_SB(0, 1), b2 + hstep, voffB);
            PG8_WAIT_V(6); PG8_BAR; PG8_MMA(1, 1, At, B1); PG8_BAR;
            PG8_LDB(B0, 1, 0); PG8_SCHED; PG8_LDA(At, 1, 0); PG8_STAGE(PG8_SA(0, 1), a2 + hstep, voffA);
            PG8_WAIT_L(8); PG8_BAR; PG8_WAIT_L(0); PG8_MMA(0, 0, At, B0); PG8_BAR; PG8_SCHED;
            PG8_LDB(B1, 1, 1); PG8_STAGE(PG8_SB(1, 0), b3, voffB);
            PG8_BAR; PG8_WAIT_L(0); PG8_MMA(0, 1, At, B1); PG8_BAR;
            PG8_LDA(At, 1, 1); PG8_STAGE(PG8_SA(1, 0), a3, voffA);
            PG8_BAR; PG8_WAIT_L(0); PG8_MMA(1, 0, At, B0); PG8_BAR; PG8_SCHED;
            PG8_STAGE(PG8_SB(1, 1), b3 + hstep, voffB);
            PG8_WAIT_V(6); PG8_BAR; PG8_MMA(1, 1, At, B1); PG8_BAR;
            }
        }
        if constexpr (ALIGN_EPI) { if (wr == 0) PG8_BAR; }
        if constexpr (!Epi::AFTER_DRAIN) { E(acc, cur, wr, wc, fr, fq); S.done(cur); }
        if (!has_next) break;
#pragma unroll
        for (int a = 0; a < 2; ++a)
#pragma unroll
            for (int b = 0; b < 2; ++b)
#pragma unroll
                for (int m = 0; m < 4; ++m)
#pragma unroll
                    for (int n = 0; n < 2; ++n) acc[a][b][m][n] = (f32x4){0.f, 0.f, 0.f, 0.f};
        cur = nxt; cA = nA; cB = nB; ++ui;
        if constexpr (SPLITK) { cA2 = (const char*)g.A2 + (size_t)cur.pm * tstep; cB2 = (const char*)g.Bt2 + (size_t)cur.pn * tstep; }
        if constexpr (ALIGN_EPI) { if (wr == 1) PG8_BAR; }
    }
    PG8_WAIT_V(0);
    if constexpr (!ALIGN_EPI) { if (wr == 0) PG8_BAR; }
    PG8_BAR;
    if constexpr (Epi::AFTER_DRAIN) { E.fused(acc, cur, wr, wc, fr, fq, lds, wid, lane); S.done(cur); }
#undef PG8_TA
#undef PG8_TB
#undef PG8_SA
#undef PG8_SB
#undef PG8_STAGE
#undef PG8_LDA
#undef PG8_LDB
#undef PG8_MMA
#undef PG8_WAIT_V
#undef PG8_WAIT_L
#undef PG8_BAR
#undef PG8_SCHED
}
}

#ifndef PG8_SP2
#define PG8_SP2 true
#endif
#ifndef PG8_ALIGN
#define PG8_ALIGN true
#endif
#include <hip/hip_bf16.h>
#include <cmath>
namespace attn_body {
using bf16=__hip_bfloat16;
using bf16x8=__attribute__((ext_vector_type(8)))short;
using s16x4=__attribute__((ext_vector_type(4)))short;
using f32x16=__attribute__((ext_vector_type(16)))float;
using u32x4=__attribute__((ext_vector_type(4)))unsigned;
constexpr int BATCH=4,NHEAD=16,SEQ=4096,D=64,DM=NHEAD*D;
constexpr int NW=8,QBLK=32,QB=QBLK*NW,KVBLK=64,NQB=SEQ/QB;
constexpr int ATTN_PITCH=DM, ATTN_UNIT_ROWS=QB;
__device__ __forceinline__ int crow(int r,int hi){return (r&3)+8*(r>>2)+4*hi;}
#define SBAR() __builtin_amdgcn_sched_barrier(0)
__device__ __forceinline__ void cmask(f32x16&p0,f32x16&p1,int jb,int qrel,int hi){
  const float NEG=-INFINITY; (void)hi;
  #pragma unroll
  for(int r=0;r<16;++r){ if(jb>(qrel>>6)){p0[r]=NEG; p1[r]=NEG;} }
}

constexpr int NSLOT=3, SLOTB=8192;
constexpr int LDS_K=0, LDS_V=NSLOT*SLOTB, LDS_WS=3*NSLOT*SLOTB, LDS_OST=LDS_WS+NW*64*4, LDS_BYTES=LDS_OST+NW*4096;
constexpr float C2=0.125f*1.4426950408889634f;
__device__ __forceinline__ void glds16(const void*gsrc,unsigned lds_dst){unsigned keep;
  asm volatile("s_mov_b32 %0, m0\n\ts_mov_b32 m0, %2\n\ts_nop 0\n\tglobal_load_lds_dwordx4 %1, off\n\ts_mov_b32 m0, %0":"=&s"(keep):"v"(gsrc),"s"(lds_dst):"memory");}
__device__ __forceinline__ float max3f(float a,float b,float c){float r;asm("v_max3_f32 %0, %1, %2, %3":"=v"(r):"v"(a),"v"(b),"v"(c));return r;}
__device__ __forceinline__ float max2f(float a,float b){float r;asm("v_max_f32_e32 %0, %1, %2":"=v"(r):"v"(a),"v"(b));return r;}
__device__ __forceinline__ float fadd_s(float a,float b){float r;asm("v_add_f32_e32 %0, %1, %2":"=v"(r):"v"(a),"v"(b));return r;}
__device__ __forceinline__ float fsub_s(float a,float b){float r;asm("v_sub_f32_e32 %0, %1, %2":"=v"(r):"v"(a),"v"(b));return r;}
typedef float f32x2_t __attribute__((ext_vector_type(2))); typedef __bf16 bf16x2_t __attribute__((ext_vector_type(2)));
__device__ __forceinline__ unsigned cvtpk_s(float lo,float hi){f32x2_t v={lo,hi};bf16x2_t b=__builtin_convertvector(v,bf16x2_t);return __builtin_bit_cast(unsigned,b);}
#define WAIT_BAR(N) asm volatile("s_waitcnt vmcnt(" #N ") lgkmcnt(0)\n\ts_barrier":::"memory")

__device__ __forceinline__ void qkt(f32x16&p0,f32x16&p1,const char*Kslot,const bf16x8*qr,const f32x16&negm,int r32,int hi){
  const char*kb=Kslot+hi*1024+r32*16;
  #pragma unroll
  for(int d0=0;d0<4;++d0){
    const bf16x8 b0=*reinterpret_cast<const bf16x8*>(kb+d0*2048);
    const bf16x8 b1=*reinterpret_cast<const bf16x8*>(kb+d0*2048+512);
    if(d0==0){p0=__builtin_amdgcn_mfma_f32_32x32x16_bf16(b0,qr[0],negm,0,0,0);p1=__builtin_amdgcn_mfma_f32_32x32x16_bf16(b1,qr[0],negm,0,0,0);}
    else{p0=__builtin_amdgcn_mfma_f32_32x32x16_bf16(b0,qr[d0],p0,0,0,0);p1=__builtin_amdgcn_mfma_f32_32x32x16_bf16(b1,qr[d0],p1,0,0,0);}}
}
typedef __attribute__((address_space(3))) const char* lds_cptr;
typedef short v4i16_t __attribute__((ext_vector_type(4)));
__device__ __forceinline__ void kload8(bf16x8*kf,lds_cptr kp){
  kf[0]=*(const __attribute__((address_space(3))) bf16x8*)(kp);      kf[1]=*(const __attribute__((address_space(3))) bf16x8*)(kp+512);
  kf[2]=*(const __attribute__((address_space(3))) bf16x8*)(kp+2048); kf[3]=*(const __attribute__((address_space(3))) bf16x8*)(kp+2560);
  kf[4]=*(const __attribute__((address_space(3))) bf16x8*)(kp+4096); kf[5]=*(const __attribute__((address_space(3))) bf16x8*)(kp+4608);
  kf[6]=*(const __attribute__((address_space(3))) bf16x8*)(kp+6144); kf[7]=*(const __attribute__((address_space(3))) bf16x8*)(kp+6656);
}
__device__ __forceinline__ void kload2(bf16x8*kf,lds_cptr kp,int j){ kf[2*j]=*(const __attribute__((address_space(3))) bf16x8*)(kp+j*2048); kf[2*j+1]=*(const __attribute__((address_space(3))) bf16x8*)(kp+j*2048+512); }
__device__ __forceinline__ s16x4 vtr(lds_cptr p){ return __builtin_bit_cast(s16x4,__builtin_amdgcn_ds_read_tr16_b64_v4i16((__attribute__((address_space(3))) v4i16_t*)p)); }
__device__ __forceinline__ float rowmax(const f32x16&p0,const f32x16&p1){
  float a=max3f(p0[0],p0[1],p1[0]),b=max3f(p0[2],p0[3],p1[1]);a=max3f(a,p1[2],p1[3]);
  #pragma unroll
  for(int r=4;r<16;r+=4){a=max3f(a,p0[r],p0[r+1]);b=max3f(b,p0[r+2],p0[r+3]);a=max3f(a,p1[r],p1[r+1]);b=max3f(b,p1[r+2],p1[r+3]);}
  const float m=max2f(a,b);
  auto rr=__builtin_amdgcn_permlane32_swap(__float_as_uint(m),__float_as_uint(m),false,false);
  return max2f(__uint_as_float(rr[0]),__uint_as_float(rr[1]));
}
__device__ __forceinline__ void pv(f32x16*o,int vb,bf16x8 pa0,bf16x8 pa1,bf16x8 pa2,bf16x8 pa3){
  #pragma unroll
  for(int d0=0;d0<4;++d0){s16x4 lo[4],hi[4];
    #pragma unroll
    for(int ks=0;ks<4;++ks){
      asm volatile("ds_read_b64_tr_b16 %0,%1 offset:%c2":"=&v"(lo[ks]):"v"(vb),"i"(d0*4096+ks*1024):"memory");
      asm volatile("ds_read_b64_tr_b16 %0,%1 offset:%c2":"=&v"(hi[ks]):"v"(vb),"i"(d0*4096+ks*1024+512):"memory");}
    asm volatile("s_waitcnt lgkmcnt(0)":::"memory");SBAR();
    #define PK(k) (bf16x8){lo[k][0],lo[k][1],lo[k][2],lo[k][3],hi[k][0],hi[k][1],hi[k][2],hi[k][3]}
    o[d0]=__builtin_amdgcn_mfma_f32_32x32x16_bf16(pa0,PK(0),o[d0],0,0,0);
    o[d0]=__builtin_amdgcn_mfma_f32_32x32x16_bf16(pa1,PK(1),o[d0],0,0,0);
    o[d0]=__builtin_amdgcn_mfma_f32_32x32x16_bf16(pa2,PK(2),o[d0],0,0,0);
    o[d0]=__builtin_amdgcn_mfma_f32_32x32x16_bf16(pa3,PK(3),o[d0],0,0,0);
    #undef PK
  }
}

#ifndef ATTN_STORE16
#define ATTN_STORE16(p,v) (*(u32x4*)(p)=(v))
#endif
template<int THRL> __device__ __forceinline__ void attn_unit(int b,int hq,int vcol,int qb,const bf16*Q,const bf16*__restrict__ K,const bf16*__restrict__ V,bf16*O,char*shm){
  int tid_l=threadIdx.x; asm volatile("":"+v"(tid_l));
  const int tid=tid_l,lane=tid&63,r32=lane&31,hi=lane>>5; const int wid=__builtin_amdgcn_readfirstlane(tid>>6);
  const long rowbase=(long)b*SEQ; const int q0=qb*QB;
  const bf16*Qw=Q+(rowbase+q0+wid*QBLK)*DM+hq*D;
  const bf16*Kh=K+rowbase*DM+hq*D,*Vh=V+rowbase*DM+vcol;
  const unsigned lds0=(unsigned)(uintptr_t)shm;
  float*wsf=(float*)(shm+LDS_WS)+wid*64;
  const bf16*ksrc=Kh+(long)lane*DM+wid*8;
  const bf16*vsrc=Vh+(long)(16*(wid&3)+(lane>>2))*DM+(wid>>2)*32+(lane&3)*8;
  const unsigned kdst=lds0+LDS_K+wid*1024, vdst=lds0+LDS_V+wid*1024;
  #define DMA_K(t,slot) glds16(ksrc+(long)(t)*KVBLK*DM,(unsigned)__builtin_amdgcn_readfirstlane(kdst+(slot)))
  #define DMA_V(t,slot) do{ glds16(vsrc+(long)(t)*KVBLK*DM,(unsigned)__builtin_amdgcn_readfirstlane(vdst+2*(slot))); glds16(vsrc+(long)(t)*KVBLK*DM+64,(unsigned)__builtin_amdgcn_readfirstlane(vdst+2*(slot)+8192)); }while(0)
  const int vb0=(int)(lds0+LDS_V)+((lane>>4)&1)*32+(lane&3)*8+(4*hi+((lane&15)>>2))*64;
  const char*Kbase=shm+LDS_K; bf16x8 kf[8];
  const lds_cptr shm3=(lds_cptr)shm; const lds_cptr kp0=shm3+LDS_K+hi*1024+r32*16; const lds_cptr vp0=shm3+LDS_V+((lane>>4)&1)*32+(lane&3)*8+(4*hi+((lane&15)>>2))*64;
  const int NT=(q0+QB)/KVBLK;
  DMA_K(0,0);DMA_V(0,0);DMA_K(1,SLOTB);
  bf16x8 qr[4];
  #pragma unroll
  for(int d0=0;d0<4;++d0)qr[d0]=*reinterpret_cast<const bf16x8*>(&Qw[(long)r32*DM+d0*16+hi*8]);
  float mhat=0.f,l_reg=0.f;f32x16 o[4];o[0]=f32x16{};o[1]=f32x16{};o[2]=f32x16{};o[3]=f32x16{};f32x16 negm=f32x16{};asm volatile("":"+v"(negm));
  const int qrel=wid*QBLK+r32;
  #define CMASK(P0,P1,t) do{int jb_=(t)-(NT-4); if(jb_>=0)cmask(P0,P1,jb_,qrel,hi);}while(0)
  bool resc=false;
  #define START(P0,P1) do{ const float rm=rowmax(P0,P1); resc=false; \
    { const float dl=rm; mhat=fadd_s(mhat,dl); \
      _Pragma("unroll") for(int r=0;r<16;++r){P0[r]=fsub_s(P0[r],dl);P1[r]=fsub_s(P1[r],dl);} \
      _Pragma("unroll") for(int r=0;r<16;++r)negm[r]=-mhat; asm volatile("":"+v"(negm)); } \
    _Pragma("unroll") for(int r=0;r<16;++r)P0[r]=__builtin_amdgcn_exp2f(P0[r]); }while(0)
  #define RESC() do{ if(resc){ asm volatile("s_waitcnt lgkmcnt(0)":::"memory"); \
      _Pragma("unroll") for(int d_=0;d_<4;++d_) _Pragma("unroll") for(int r=0;r<16;++r)o[d_][r]*=wsf[crow(r,hi)]; } }while(0)
  f32x16 pA0,pA1,pB0,pB1;
  int sl_prev=0,sl_cur=0,sl_next=SLOTB;
  #define ROT() do{sl_prev=sl_cur;sl_cur=sl_next;sl_next=(sl_next==(NSLOT-1)*SLOTB)?0:sl_next+SLOTB;}while(0)
  DMA_K(2,2*SLOTB);
  WAIT_BAR(4);
  qkt(pA0,pA1,Kbase,qr,negm,r32,hi);asm volatile("s_nop 15\n\ts_nop 7":"+v"(pA0),"+v"(pA1));CMASK(pA0,pA1,0);
  START(pA0,pA1);
  _Pragma("unroll") for(int r=0;r<16;++r)pA1[r]=__builtin_amdgcn_exp2f(pA1[r]);
  WAIT_BAR(0);
  DMA_K(3,0);DMA_V(1,SLOTB);
  ROT();
  kload8(kf,kp0+sl_cur);
  WAIT_BAR(3);
  s16x4 vlo[4],vhi[4]; u32x4 pw0,pw1,pw2,pw3;
  #define PKW(P,B) cvtpk_s(P[B],P[B+1])
  #define PAF(k) __builtin_bit_cast(bf16x8,pw##k)
  #define VFR(i) (bf16x8){vlo[i][0],vlo[i][1],vlo[i][2],vlo[i][3],vhi[i][0],vhi[i][1],vhi[i][2],vhi[i][3]}
  #define VRDJ(d,ks) do{ vlo[d]=vtr(vp_+((d)*4096+(ks)*1024)); vhi[d]=vtr(vp_+((d)*4096+(ks)*1024+512)); }while(0)
  #define GAPB2(MF,X,B) do{ MF; X[B]=EX(X[B]); X[B+1]=EX(X[B+1]); PIN(X); SBAR(); }while(0)
  #define PVM(d,ks) o[d]=__builtin_amdgcn_mfma_f32_32x32x16_bf16(PAF(ks),VFR(d),o[d],0,0,0)
  #define PIN(x) asm volatile("":"+v"(x))
  #define MX3(a,b,c) __builtin_fmaxf(__builtin_fmaxf((a),(b)),(c))
  #define GAPA(MF,A0,A1,A2,A3,W0,W1,PW) do{ MF; sacc+=A0; sacc+=A1; sacc+=A2; sacc+=A3; PIN(sacc); W0; W1; PIN(PW); SBAR(); }while(0)
  #define EX(v) __builtin_amdgcn_exp2f(v)
  #define GAPB(MF,X,B) do{ MF; X[B]=EX(X[B]); X[B+1]=EX(X[B+1]); X[B+2]=EX(X[B+2]); X[B+3]=EX(X[B+3]); PIN(X); SBAR(); }while(0)
  #define VRD(i) do{ vlo[i]=vtr(vp_+(((i)>>2)*4096+((i)&3)*1024)); vhi[i]=vtr(vp_+(((i)>>2)*4096+((i)&3)*1024+512)); }while(0)
  #define KRD(G,j) do{ if(G){ kload2(kf,kp0+sl_next,j); SBAR(); } }while(0)
  #define STEP(C0,C1,P0,P1,t,GK,GV,GL) do{ SBAR(); \
    const lds_cptr vp_=vp0+2*sl_prev; \
    float sacc=(P0[0]+P0[1]); \
    GAPA(C0=__builtin_amdgcn_mfma_f32_32x32x16_bf16(kf[0],qr[0],negm,0,0,0), P0[2],P0[3],P0[4],P0[5],     pw0[0]=PKW(P0,0), pw0[1]=PKW(P0,2), pw0); \
    GAPA(C1=__builtin_amdgcn_mfma_f32_32x32x16_bf16(kf[1],qr[0],negm,0,0,0), P0[6],P0[7],P0[8],P0[9],     pw0[2]=PKW(P0,4), pw0[3]=PKW(P0,6), pw0); \
    GAPA(C0=__builtin_amdgcn_mfma_f32_32x32x16_bf16(kf[2],qr[1],C0,0,0,0),   P0[10],P0[11],P0[12],P0[13], pw1[0]=PKW(P0,8), pw1[1]=PKW(P0,10), pw1); \
    GAPA(C1=__builtin_amdgcn_mfma_f32_32x32x16_bf16(kf[3],qr[1],C1,0,0,0),   P0[14],P0[15],P1[0],P1[1],   pw1[2]=PKW(P0,12),pw1[3]=PKW(P0,14), pw1); \
    GAPA(C0=__builtin_amdgcn_mfma_f32_32x32x16_bf16(kf[4],qr[2],C0,0,0,0),   P1[2],P1[3],P1[4],P1[5],     pw2[0]=PKW(P1,0), pw2[1]=PKW(P1,2), pw2); \
    GAPA(C1=__builtin_amdgcn_mfma_f32_32x32x16_bf16(kf[5],qr[2],C1,0,0,0),   P1[6],P1[7],P1[8],P1[9],     pw2[2]=PKW(P1,4), pw2[3]=PKW(P1,6), pw2); \
    GAPA(C0=__builtin_amdgcn_mfma_f32_32x32x16_bf16(kf[6],qr[3],C0,0,0,0),   P1[10],P1[11],P1[12],P1[13], pw3[0]=PKW(P1,8), pw3[1]=PKW(P1,10), pw3); \
    GAPA(C1=__builtin_amdgcn_mfma_f32_32x32x16_bf16(kf[7],qr[3],C1,0,0,0),   P1[14],P1[15],0.f,0.f,       pw3[2]=PKW(P1,12),pw3[3]=PKW(P1,14), pw3); \
    l_reg+=sacc; \
    VRDJ(0,0); VRDJ(1,0); VRDJ(2,0); VRDJ(3,0); SBAR(); \
    if(GK){DMA_K((t)+3,sl_cur);} if(GV){DMA_V((t)+1,sl_next);} \
    CMASK(C0,C1,t); \
    { float a=MX3(C0[0],C0[1],C1[0]),b=MX3(C0[2],C0[3],C1[1]); a=MX3(a,C1[2],C1[3]); \
      _Pragma("unroll") for(int r=4;r<16;r+=4){a=MX3(a,C0[r],C0[r+1]);b=MX3(b,C0[r+2],C0[r+3]);a=MX3(a,C1[r],C1[r+1]);b=MX3(b,C1[r+2],C1[r+3]);} \
      float rm=__builtin_fmaxf(a,b); { auto rr=__builtin_amdgcn_permlane32_swap(__float_as_uint(rm),__float_as_uint(rm),false,false); rm=__builtin_fmaxf(__uint_as_float(rr[0]),__uint_as_float(rr[1])); } \
      resc=false; \
      if(__builtin_expect(__any(rm>(float)THRL),0)){ const float dl=__builtin_fmaxf(rm,0.f); mhat+=dl; \
        _Pragma("unroll") for(int r=0;r<16;++r){C0[r]-=dl;C1[r]-=dl;} \
        _Pragma("unroll") for(int r=0;r<16;++r)negm[r]=-mhat; asm volatile("":"+v"(negm)); \
        const float f=__builtin_amdgcn_exp2f(-dl); l_reg*=f; if(hi==0)wsf[r32]=f; resc=true; } } \
    SBAR(); \
    GAPB2(PVM(0,0), C0,0);  VRDJ(0,1); SBAR(); \
    GAPB2(PVM(1,0), C0,2);  VRDJ(1,1); SBAR(); \
    GAPB2(PVM(2,0), C0,4);  VRDJ(2,1); SBAR(); \
    GAPB2(PVM(3,0), C0,6);  VRDJ(3,1); SBAR(); \
    KRD(GL,0); GAPB2(PVM(0,1), C0,8);  VRDJ(0,2); SBAR(); \
    KRD(GL,1); GAPB2(PVM(1,1), C0,10); VRDJ(1,2); SBAR(); \
    KRD(GL,2); GAPB2(PVM(2,1), C0,12); VRDJ(2,2); SBAR(); \
    KRD(GL,3); GAPB2(PVM(3,1), C0,14); VRDJ(3,2); SBAR(); \
    GAPB2(PVM(0,2), C1,0);  VRDJ(0,3); SBAR(); \
    GAPB2(PVM(1,2), C1,2);  VRDJ(1,3); SBAR(); \
    GAPB2(PVM(2,2), C1,4);  VRDJ(2,3); SBAR(); \
    GAPB2(PVM(3,2), C1,6);  VRDJ(3,3); SBAR(); \
    GAPB2(PVM(0,3), C1,8); \
    GAPB2(PVM(1,3), C1,10); \
    GAPB2(PVM(2,3), C1,12); \
    GAPB2(PVM(3,3), C1,14); \
    }while(0)
  int t=1;
  #undef CMASK
  #define CMASK(P0,P1,t) do{}while(0)
  for(;t+5<NT;t+=2){
    STEP(pB0,pB1,pA0,pA1,t,true,true,true);     WAIT_BAR(3); RESC(); ROT();
    STEP(pA0,pA1,pB0,pB1,t+1,true,true,true);   WAIT_BAR(3); RESC(); ROT();
  }
  #undef CMASK
  #define CMASK(P0,P1,t) do{int jb_=(t)-(NT-4); if(jb_>=0)cmask(P0,P1,jb_,qrel,hi);}while(0)
  #define ENDW(tt) do{ if((tt)+3<NT){WAIT_BAR(3);} else if((tt)+2<NT){WAIT_BAR(2);} else {WAIT_BAR(0);} }while(0)
  for(;t+1<NT;t+=2){
    STEP(pB0,pB1,pA0,pA1,t,(t+3<NT),(t+1<NT),(t+1<NT));       ENDW(t);   RESC(); ROT();
    STEP(pA0,pA1,pB0,pB1,t+1,(t+4<NT),(t+2<NT),(t+2<NT));     ENDW(t+1); RESC(); ROT();
  }
  STEP(pB0,pB1,pA0,pA1,NT-1,false,false,false); RESC();
  { float sacc=pB0[0]+pB0[1]; _Pragma("unroll") for(int r=2;r<16;++r)sacc+=pB0[r]; _Pragma("unroll") for(int r=0;r<16;++r)sacc+=pB1[r]; l_reg+=sacc;
    pw0=(u32x4){PKW(pB0,0),PKW(pB0,2),PKW(pB0,4),PKW(pB0,6)};pw1=(u32x4){PKW(pB0,8),PKW(pB0,10),PKW(pB0,12),PKW(pB0,14)};pw2=(u32x4){PKW(pB1,0),PKW(pB1,2),PKW(pB1,4),PKW(pB1,6)};pw3=(u32x4){PKW(pB1,8),PKW(pB1,10),PKW(pB1,12),PKW(pB1,14)};
    SBAR(); pv(o,vb0+2*sl_cur,PAF(0),PAF(1),PAF(2),PAF(3)); }
  #undef PKW
  #undef PAF
  #undef VFR
  #undef PIN
  #undef MX3
  #undef GAPA
  #undef GAPB
  #undef EX
  #undef VRD
  #undef VRDJ
  #undef GAPB2
  #undef PVM
  #undef KRD
  #undef STEP
  #undef ENDW
  {auto rr=__builtin_amdgcn_permlane32_swap(__float_as_uint(l_reg),__float_as_uint(l_reg),false,false);l_reg=__uint_as_float(rr[0])+__uint_as_float(rr[1]);}
  if(hi==0)wsf[32+r32]=l_reg;asm volatile("s_waitcnt lgkmcnt(0)":::"memory");
  float rli[16];
  #pragma unroll
  for(int r=0;r<16;++r)rli[r]=__builtin_amdgcn_rcpf(wsf[32+crow(r,hi)]);
  bf16*Ow=O+(rowbase+q0+wid*QBLK)*DM+vcol;
  { bf16*stg=(bf16*)(shm+LDS_OST)+wid*2048;
    #pragma unroll
    for(int hf=0;hf<2;++hf){
      #pragma unroll
      for(int r=0;r<16;++r){const int orow=crow(r,hi);
        #pragma unroll
        for(int d0=0;d0<2;++d0)stg[orow*64+d0*32+r32]=__float2bfloat16(o[2*hf+d0][r]*rli[r]);}
      asm volatile("s_waitcnt lgkmcnt(0)":::"memory");
      #pragma unroll
      for(int i=0;i<4;++i){const int row=i*8+(lane>>3),ch=lane&7; const u32x4 v=*(const u32x4*)(stg+row*64+ch*8); ATTN_STORE16(Ow+(long)row*DM+hf*64+ch*8,v);}
      asm volatile("s_waitcnt lgkmcnt(0)":::"memory"); } }
  asm volatile("s_waitcnt lgkmcnt(0)\n\ts_barrier":::"memory");
  #undef DMA_K
  #undef DMA_V
  #undef CMASK
  #undef START
  #undef RESC
  #undef ROT
}
constexpr int ATTN_LDS_BYTES=LDS_BYTES;
#undef SBAR
#undef WAIT_BAR
}
#define LAS __attribute__((address_space(3)))
typedef unsigned short bf16u;
typedef unsigned v4u __attribute__((ext_vector_type(4)));
typedef float f32x4 __attribute__((ext_vector_type(4)));
using pg8::pack8; using pg8::unpack8; using pg8::row_rstd;

#define XB_TMO      128
#define XB_XCNT(j)  (256  + 64 * (j))
#define XB_XSUB(j)  (1280 + 64 * (j))
#define XB_XGEN(j)  (2304 + 64 * (j))
#define XB_TOP      3328
#define XB_TOPGEN   3392
#define XCD_BAR_WORDS 3456
#define XB_SPIN_CAP (1u << 18)

__device__ __forceinline__ unsigned xb_ld(unsigned* p)              { return __hip_atomic_load(p, __ATOMIC_RELAXED, __HIP_MEMORY_SCOPE_AGENT); }
__device__ __forceinline__ unsigned xb_add(unsigned* p, unsigned v) { return __hip_atomic_fetch_add(p, v, __ATOMIC_RELAXED, __HIP_MEMORY_SCOPE_AGENT); }
__device__ __forceinline__ unsigned xb_xcc_id() { return (unsigned)__builtin_amdgcn_s_getreg((3 << 11) | 20) & 0xFu; }
#define XB_SPIN(cond, bar) do { unsigned _sp = 0; while (cond) { __builtin_amdgcn_s_sleep(1); \
    if ((++_sp & 255u) == 0u) { if (xb_ld(&(bar)[XB_TMO])) break; if (_sp > XB_SPIN_CAP) { atomicAdd(&(bar)[XB_TMO], 1u); break; } } } } while (0)

struct XcdBarrier {
    unsigned* bar; unsigned x;
    volatile LAS unsigned* st;
};

__device__ __forceinline__ XcdBarrier xcd_barrier_post(unsigned* bar, volatile LAS unsigned* st) {
    XcdBarrier b; b.bar = bar; b.x = xb_xcc_id(); b.st = st;
    if (threadIdx.x == 0) (void)xb_add(&bar[XB_XCNT(b.x)], 1u);
    return b;
}
__device__ __forceinline__ void xcd_barrier_complete(unsigned* bar, unsigned x, unsigned& nloc, unsigned& nx) {
    const unsigned G = gridDim.x * gridDim.y * gridDim.z;
    unsigned sum, cnt, mine, sp = 0u;
    for (;;) {
        sum = 0u; cnt = 0u; mine = 0u;
#pragma unroll
        for (unsigned j = 0; j < 16; ++j) { const unsigned c = xb_ld(&bar[XB_XCNT(j)]); sum += c; cnt += (c > 0u) ? 1u : 0u; mine = (j == x) ? c : mine; }
        if (sum == G) break;
        __builtin_amdgcn_s_sleep(1);
        if ((++sp & 255u) == 0u) { if (xb_ld(&bar[XB_TMO])) break; if (sp > XB_SPIN_CAP) { atomicAdd(&bar[XB_TMO], 1u); break; } }
    }
    nloc = mine > 0u ? mine : 1u; nx = cnt > 0u ? cnt : 1u;
}

__device__ __forceinline__ void xcd_barrier(const XcdBarrier& b) {
    asm volatile("s_waitcnt vmcnt(0)" ::: "memory");
    __syncthreads();
    if (threadIdx.x == 0) {
        unsigned* bar = b.bar;
        __builtin_amdgcn_s_waitcnt(0);
        unsigned nloc = b.st[0], nx = b.st[1];
        if (nloc == 0u) { xcd_barrier_complete(bar, b.x, nloc, nx); b.st[0] = nloc; b.st[1] = nx; }
        const unsigned old = xb_add(&bar[XB_XSUB(b.x)], 1u);
        const unsigned gen = old / nloc;
        if (old + 1u == (gen + 1u) * nloc) {
            __builtin_amdgcn_fence(__ATOMIC_RELEASE, "agent");
            asm volatile("s_waitcnt vmcnt(0)" ::: "memory");
            const unsigned og = xb_add(&bar[XB_TOP], 1u);
            const unsigned tg = og / nx;
            if (og + 1u == (tg + 1u) * nx) xb_add(&bar[XB_TOPGEN], 1u);
            else XB_SPIN(xb_ld(&bar[XB_TOPGEN]) == tg, bar);
            __builtin_amdgcn_fence(__ATOMIC_ACQUIRE, "agent");
            xb_add(&bar[XB_XGEN(b.x)], 1u);
            asm volatile("s_waitcnt vmcnt(0)" ::: "memory");
        } else {
            XB_SPIN(xb_ld(&bar[XB_XGEN(b.x)]) == gen, bar);
            __builtin_amdgcn_fence(__ATOMIC_ACQUIRE, "agent");
            asm volatile("s_waitcnt vmcnt(0)" ::: "memory");
        }
    }
    __syncthreads();
}


constexpr int NWAVES = 8;
constexpr int NTOK = 16384, DMOD = 1024, SEQL = 4096, NLAYER = 4, DFF = 2816, INW = 8192;
constexpr size_t MiB = 1u << 20;
constexpr size_t WS_ROPE = 0;
constexpr size_t WS_SSQA = 1 * MiB, WS_SSQB = 2 * MiB;
constexpr size_t WS_BAR = 3 * MiB + 65536, BAR_ZERO_BYTES = 65536;
constexpr size_t WS_LAM = 3 * MiB;
constexpr size_t WS_W = 4 * MiB, W_LAYER = 77 * MiB / 2;
constexpr size_t WL_IN = 0, WL_A = 16 * MiB, WL_B = 18 * MiB, WL_O = 20 * MiB, WL_GU = 22 * MiB, WL_D = 33 * MiB;
constexpr size_t WS_XB = 158 * MiB;
constexpr size_t BUFB = 32 * MiB, BUFE = BUFB / 2;
constexpr size_t WS_Q = 190 * MiB;
constexpr size_t WS_ACT = WS_Q;
constexpr size_t WS_STASH = WS_Q + 4 * BUFB;
constexpr size_t WS_O1 = 446 * MiB, WS_O2 = 478 * MiB;
constexpr size_t WS_END = 510 * MiB;
static_assert(WS_W + 4 * W_LAYER == WS_XB && (size_t)NTOK * DFF * 2 <= 3 * BUFB, "ws map");
constexpr int RING_BYTES = 131072, LDS_BYTES = 147456;

__device__ __forceinline__ float wave_sum(float v) {
#pragma unroll
    for (int o = 1; o < 64; o <<= 1) v += __shfl_xor(v, o);
    return v;
}
__device__ __forceinline__ unsigned f2bf(float f) { unsigned u = __builtin_bit_cast(unsigned, f); return (u + 0x7fffu + ((u >> 16) & 1u)) >> 16; }
__device__ __forceinline__ unsigned pk2(float lo, float hi) { return pg8::cvt_pk_bf16(lo, hi); }

template <int MODE>
__device__ __forceinline__ void p0_item(const float* W, int K, int N, bf16u* WT, const float* ks, LAS float* scr, int item, int lane) {
    const int nblk = N / 64, kb = item / nblk, nb = item - kb * nblk, k0 = 64 * kb, n0 = 64 * nb;
    int nn = n0 + lane;
    if (MODE == 1) {
        if (nn < 2048) { const int p = nn & 63; if (p < 16) nn = (nn & ~15) | (p & 3) | ((p & 4) << 1) | ((p & 8) >> 1); }
        else if (nn >= 4096) { const int sec = nn >= 6144 ? 6144 : 4096, r = nn - sec, q = r & 255; nn = sec + ((q >> 7) << 10) + 128 * (r >> 8) + (q & 127); }
    }
    int drow = n0;
    if (MODE == 2) drow = 256 * (n0 >> 7) + (n0 & 127);
    if (MODE == 3) drow = 256 * (n0 >> 7) + 128 + (n0 & 127);
    const float* src = W + (size_t)k0 * N + nn;
    float v[64];
#pragma unroll
    for (int kk = 0; kk < 64; ++kk) v[kk] = src[(size_t)kk * N];
    if (ks) {
#pragma unroll
        for (int kk = 0; kk < 64; ++kk) v[kk] *= ks[k0 + kk];
    }
#pragma unroll
    for (int kk = 0; kk < 64; ++kk) scr[kk * 65 + lane] = v[kk];
    asm volatile("s_waitcnt lgkmcnt(0)" ::: "memory");
    const int c = lane & 7;
#pragma unroll
    for (int j = 0; j < 8; ++j) { const int n = (lane >> 3) + 8 * j; const LAS float* s = scr + (8 * c) * 65 + n;
        v4u o; o.x = pk2(s[0 * 65], s[1 * 65]); o.y = pk2(s[2 * 65], s[3 * 65]); o.z = pk2(s[4 * 65], s[5 * 65]); o.w = pk2(s[6 * 65], s[7 * 65]);
        *(v4u*)(WT + (size_t)(drow + n) * K + k0 + 8 * c) = o; }
    asm volatile("s_waitcnt lgkmcnt(0)" ::: "memory");
}

__device__ __forceinline__ void conv_items(bf16u* BGb, const bf16u* CGb, const float* cw, int vcup, int G) {
    int tidp = threadIdx.x; asm volatile("" : "+v"(tidp));
    const int qd = tidp >> 7, c0 = (tidp & 127) * 8;
    float w0[8], w1[8], w2[8];
#pragma unroll
    for (int e = 0; e < 8; ++e) { w0[e] = cw[c0 + e]; w1[e] = cw[DMOD + c0 + e]; w2[e] = cw[2 * DMOD + c0 + e]; }
    for (int item = vcup * 4 + qd; item < NTOK / 16; item += G * 4) {
        const int r0 = item * 16;
        f32x4 p2a = (f32x4){0.f, 0.f, 0.f, 0.f}, p2b = p2a, p1a = p2a, p1b = p2a;
        if ((r0 & (SEQL - 1)) != 0) {
            unpack8(*(const v4u*)(CGb + (size_t)(r0 - 2) * DMOD + c0), p2a, p2b);
            unpack8(*(const v4u*)(CGb + (size_t)(r0 - 1) * DMOD + c0), p1a, p1b);
        }
#pragma unroll 8
        for (int i = 0; i < 16; ++i) {
            const size_t off = (size_t)(r0 + i) * DMOD + c0;
            f32x4 p0a, p0b, ba, bb;
            unpack8(*(const v4u*)(CGb + off), p0a, p0b); unpack8(*(const v4u*)(BGb + off), ba, bb);
            f32x4 ya, yb;
#pragma unroll
            for (int e = 0; e < 4; ++e) { ya[e] = ba[e] * (w0[e] * p2a[e] + w1[e] * p1a[e] + w2[e] * p0a[e]); yb[e] = bb[e] * (w0[4 + e] * p2b[e] + w1[4 + e] * p1b[e] + w2[4 + e] * p0b[e]); }
            *(v4u*)(BGb + off) = pack8(ya, yb);
            p2a = p1a; p2b = p1b; p1a = p0a; p1b = p0b;
        }
    }
}

constexpr int I_IN = (DMOD / 64) * (INW / 64), I_SQ = (DMOD / 64) * (DMOD / 64), I_G = (DMOD / 64) * (DFF / 64), I_D = (DFF / 64) * (DMOD / 64);
constexpr int I_LAYER = I_IN + 3 * I_SQ + 2 * I_G + I_D;
#define CONVERT_LAYER(LYR, START, STRIDE, LANE) do { \
        LAS float* scr_ = (LAS float*)(L + wave * 17408); const int l_ = (LYR); unsigned char* wl_ = ws + WS_W + (size_t)l_ * W_LAYER; \
        for (int it_ = (START); it_ < I_LAYER; it_ += (STRIDE)) { int r_ = it_; \
            if (r_ < I_IN) { p0_item<1>(w_in + (size_t)l_ * DMOD * INW, DMOD, INW, (bf16u*)(wl_ + WL_IN), mix_norm + l_ * DMOD, scr_, r_, LANE); continue; } r_ -= I_IN; \
            if (r_ < I_SQ) { p0_item<0>(w_a + (size_t)l_ * DMOD * DMOD, DMOD, DMOD, (bf16u*)(wl_ + WL_A), nullptr, scr_, r_, LANE); continue; } r_ -= I_SQ; \
            if (r_ < I_SQ) { p0_item<0>(w_b + (size_t)l_ * DMOD * DMOD, DMOD, DMOD, (bf16u*)(wl_ + WL_B), nullptr, scr_, r_, LANE); continue; } r_ -= I_SQ; \
            if (r_ < I_SQ) { p0_item<0>(w_o + (size_t)l_ * DMOD * DMOD, DMOD, DMOD, (bf16u*)(wl_ + WL_O), nullptr, scr_, r_, LANE); continue; } r_ -= I_SQ; \
            if (r_ < I_G) { p0_item<2>(w_gate + (size_t)l_ * DMOD * DFF, DMOD, DFF, (bf16u*)(wl_ + WL_GU), ffn_norm + l_ * DMOD, scr_, r_, LANE); continue; } r_ -= I_G; \
            if (r_ < I_G) { p0_item<3>(w_up + (size_t)l_ * DMOD * DFF, DMOD, DFF, (bf16u*)(wl_ + WL_GU), ffn_norm + l_ * DMOD, scr_, r_, LANE); continue; } r_ -= I_G; \
            p0_item<0>(w_down + (size_t)l_ * DFF * DMOD, DFF, DMOD, (bf16u*)(wl_ + WL_D), nullptr, scr_, r_, LANE); \
        } } while (0)

#define REP_SYNC 1
#define REP_P0 1
#define REP_P1 1
#define REP_P3 1
#define REP_P5 1
#define GSYNC() do { for (int r_ = 0; r_ < REP_SYNC; ++r_) xcd_barrier(bar); } while (0)
struct Args { const void* in[18]; float* out; unsigned char* ws; float linit[4]; float freq[8]; };

__global__ void __launch_bounds__(NWAVES * 64, 2) mk_fwd(Args a) {
    extern __shared__ __attribute__((aligned(16))) unsigned char lds[];
    cg::grid_group grid = cg::this_grid();
    LAS unsigned char* L = (LAS unsigned char*)lds;
    const int tid = threadIdx.x, lane = tid & 63, wave = __builtin_amdgcn_readfirstlane(tid >> 6);
    const int G = gridDim.x, bx = blockIdx.x;
    const int vcu = (G % 8 == 0) ? (bx % 8) * (G / 8) + bx / 8 : bx;
    unsigned char* ws = a.ws;
    const float* x_in = (const float*)a.in[0]; const int* positions = (const int*)a.in[1];
    const float* mix_norm = (const float*)a.in[2]; const float* w_in = (const float*)a.in[3];
    const float* lq1 = (const float*)a.in[4]; const float* lk1 = (const float*)a.in[5]; const float* lq2 = (const float*)a.in[6]; const float* lk2 = (const float*)a.in[7];
    const float* subln_w = (const float*)a.in[8]; const float* conv_w = (const float*)a.in[9];
    const float* w_a = (const float*)a.in[10]; const float* w_b = (const float*)a.in[11]; const float* w_o = (const float*)a.in[12];
    const float* ffn_norm = (const float*)a.in[13]; const float* w_gate = (const float*)a.in[14]; const float* w_up = (const float*)a.in[15]; const float* w_down = (const float*)a.in[16];
    const float* final_norm = (const float*)a.in[17];
    float* out = a.out;
    float* rope = (float*)(ws + WS_ROPE); float* ssqA = (float*)(ws + WS_SSQA); float* ssqB = (float*)(ws + WS_SSQB); float* lamtab = (float*)(ws + WS_LAM);
    bf16u* XB = (bf16u*)(ws + WS_XB);
    bf16u* Qb = (bf16u*)(ws + WS_Q); bf16u* Kb = Qb + BUFE; bf16u* Vb = Qb + 2 * BUFE; bf16u* BGb = Qb + 3 * BUFE; bf16u* CGb = Qb + 4 * BUFE; bf16u* Ub = Qb + 5 * BUFE;
    bf16u* SGA = Qb + 6 * BUFE; bf16u* SGB = Qb + 7 * BUFE;
    bf16u* ACT = (bf16u*)(ws + WS_ACT); float* STASH = (float*)(ws + WS_STASH);
    bf16u* O1 = (bf16u*)(ws + WS_O1); bf16u* O2 = (bf16u*)(ws + WS_O2); bf16u* MIXED = O1;
    const int gw = vcu * NWAVES + wave, NGW = G * NWAVES;
    volatile LAS unsigned* MISC = (volatile LAS unsigned*)(L + LDS_BYTES - 64);
    if (tid < 2) MISC[tid] = 0u;
    __syncthreads();
    const XcdBarrier bar = xcd_barrier_post((unsigned*)(ws + WS_BAR), MISC);

#pragma unroll 1
    for (int rep0 = 0; rep0 < REP_P0; ++rep0) {
        CONVERT_LAYER(0, gw, NGW, lane);
        for (int idx = (vcu * NWAVES * 64) + tid; idx < NTOK * 8; idx += G * NWAVES * 64) {
            const int row = idx >> 3, j = idx & 7;
            const float ang = (float)positions[row] * a.freq[j];
            rope[(size_t)row * 16 + j] = cosf(ang); rope[(size_t)row * 16 + 8 + j] = sinf(ang);
        }
        for (int m = gw; m < NTOK; m += NGW) {
            const f32x4* xr = (const f32x4*)(x_in + (size_t)m * DMOD) + lane;
            f32x4 v[4]; float s = 0.f;
#pragma unroll
            for (int j = 0; j < 4; ++j) { v[j] = xr[64 * j]; s += (v[j].x * v[j].x + v[j].y * v[j].y) + (v[j].z * v[j].z + v[j].w * v[j].w); }
            s = wave_sum(s);
            unsigned long long* o8 = (unsigned long long*)(XB + (size_t)m * DMOD) + lane;
#pragma unroll
            for (int j = 0; j < 4; ++j) o8[64 * j] = (unsigned long long)pk2(v[j].x, v[j].y) | ((unsigned long long)pk2(v[j].z, v[j].w) << 32);
            if (lane < 16) ssqA[(size_t)m * 16 + lane] = (lane == 0) ? s : 0.f;
        }
        if (vcu == 0 && wave == 0) {
            for (int l = 0; l < NLAYER; ++l) {
                const float s1 = wave_sum(lq1[l * 64 + lane] * lk1[l * 64 + lane]), s2 = wave_sum(lq2[l * 64 + lane] * lk2[l * 64 + lane]);
                if (lane == 0) lamtab[l] = expf(s1) - expf(s2) + a.linit[l];
            }
        }
    }
    if (a.ws == nullptr) grid.sync();
    GSYNC();

#pragma unroll 1
    for (int l = 0; l < NLAYER; ++l) {
        unsigned char* wl = ws + WS_W + (size_t)l * W_LAYER;
#pragma unroll 1
        for (int rep1 = 0; rep1 < REP_P1; ++rep1) {
            pg8::Gemm g{XB, (const bf16u*)(wl + WL_IN), NTOK, INW, DMOD}; int bxp = bx; asm volatile("" : "+s"(bxp)); pg8::StaticOrder S; S.init(NTOK, INW, G, bxp);
            pg8::Unit u0; int pm0 = -1; if (S.next(0, u0)) pm0 = u0.pm;
            { int tt_ = threadIdx.x; asm volatile("" : "+v"(tt_)); if (pm0 >= 0 && tt_ < 256) ((LAS float*)(L + RING_BYTES))[tt_] = pg8::row_rstd(ssqA, pm0 * 256 + tt_); }
            __syncthreads();
            pg8::EpiProj E{Qb, BUFE, ssqA, rope, attn_body::C2, pm0, (const LAS float*)(L + RING_BYTES)};
            pg8::gemm_phase<pg8::EpiProj, pg8::StaticOrder, true, true>(L, g, S, E);
        }
        GSYNC();
        {
            int vcup = vcu; asm volatile("" : "+s"(vcup));
            const float lam = lamtab[l], osc = 1.0f - a.linit[l];
            const float* sw = subln_w + l * 128;
            const int convslot = (G == 256) ? (vcup & 3) : 0; int ucount = 0; bool conv_done = false;
#pragma unroll 1
            for (int gidx = vcup; gidx < 512; gidx += G) {
                const int gi = gidx >> 8, v = gidx & 255, bh = v >> 3, s = v & 7, qb = gi ? 15 - s : s, b = bh >> 3, h = bh & 7;
#pragma unroll 1
                for (int m = 0; m < 2; ++m) {
                    if (ucount == convslot) { conv_items(BGb, CGb, conv_w + (size_t)l * 3 * DMOD, vcup, G); conv_done = true; }
                    ++ucount;
                    attn_body::attn_unit<8>(b, 2 * h + m, 128 * h, qb, (const attn_body::bf16*)Qb, (const attn_body::bf16*)Kb, (const attn_body::bf16*)Vb, (attn_body::bf16*)(m ? O2 : O1), (char*)lds);
                }
                asm volatile("s_waitcnt vmcnt(0)" ::: "memory");
                int tl_ = threadIdx.x; asm volatile("" : "+v"(tl_)); const int ln = tl_ & 63;
                const int c8 = (ln & 15) * 8;
                const f32x4 sw0 = *(const f32x4*)(sw + c8), sw1 = *(const f32x4*)(sw + c8 + 4);
                const size_t R0 = (size_t)b * SEQL + 256 * qb + 32 * wave;
#pragma unroll 2
                for (int it = 0; it < 8; ++it) {
                    const size_t off = (R0 + 4 * it + (ln >> 4)) * DMOD + 128 * h + c8;
                    f32x4 a0, a1, b0, b1; unpack8(*(const v4u*)(O1 + off), a0, a1); unpack8(*(const v4u*)(O2 + off), b0, b1);
                    const f32x4 d0 = a0 - b0 * lam, d1 = a1 - b1 * lam;
                    float ss = (d0[0] * d0[0] + d0[1] * d0[1]) + (d0[2] * d0[2] + d0[3] * d0[3]) + (d1[0] * d1[0] + d1[1] * d1[1]) + (d1[2] * d1[2] + d1[3] * d1[3]);
                    ss += pg8::shfl_xor_l(ss, 1, ln); ss += pg8::shfl_xor_l(ss, 2, ln); ss += pg8::shfl_xor_l(ss, 4, ln); ss += pg8::shfl_xor_l(ss, 8, ln);
                    const float rs = osc * __builtin_amdgcn_rsqf(ss * (1.0f / 128.0f) + 1e-6f);
                    *(v4u*)(Qb + off) = pack8(d0 * rs * sw0, d1 * rs * sw1);
                }
            }
            if (!conv_done) conv_items(BGb, CGb, conv_w + (size_t)l * 3 * DMOD, vcup, G);
        }
        GSYNC();
#pragma unroll 1
        for (int rep3 = 0; rep3 < REP_P3; ++rep3) {
            int bxp = bx; asm volatile("" : "+s"(bxp)); pg8::StaticOrder S; S.init(NTOK, DMOD, G, bxp);
            pg8::Gemm g{Qb, (const bf16u*)(wl + WL_A), NTOK, DMOD, DMOD, BGb, (const bf16u*)(wl + WL_B)}; pg8::EpiMix2 E{SGA, SGB, MIXED};
            pg8::gemm_phase<pg8::EpiMix2, pg8::StaticOrder, true, true, true>(L, g, S, E);
        }
        GSYNC();
        {
            pg8::Gemm g{MIXED, (const bf16u*)(wl + WL_O), NTOK, DMOD, DMOD}; int bxp = bx; asm volatile("" : "+s"(bxp)); pg8::StaticOrder S; S.init(NTOK, DMOD, G, bxp);
            pg8::EpiResid E{XB, ssqB};
            pg8::gemm_phase<pg8::EpiResid, pg8::StaticOrder, true, true>(L, g, S, E);
        }
        GSYNC();
#pragma unroll 1
        for (int rep5 = 0; rep5 < REP_P5; ++rep5) {
            pg8::Gemm g{XB, (const bf16u*)(wl + WL_GU), NTOK, 2 * DFF, DMOD}; int bxp = bx; asm volatile("" : "+s"(bxp)); pg8::StaticOrder S; S.init(NTOK, 2 * DFF, G, bxp);
            pg8::Unit u0; int pm0 = -1; if (S.next(0, u0)) pm0 = u0.pm;
            { int tt_ = threadIdx.x; asm volatile("" : "+v"(tt_)); if (pm0 >= 0 && tt_ < 256) ((LAS float*)(L + RING_BYTES))[tt_] = pg8::row_rstd(ssqB, pm0 * 256 + tt_); }
            __syncthreads();
            pg8::EpiSwiGLU E{ACT, DFF, ssqB, pm0, (const LAS float*)(L + RING_BYTES)};
            pg8::gemm_phase<pg8::EpiSwiGLU, pg8::StaticOrder, true, true>(L, g, S, E);
            if (l + 1 < NLAYER && rep5 == 0) {
                const int nwg5 = (NTOK / 256) * (2 * DFF / 256), rem = nwg5 % G;
                const bool light = (rem == 0) || (bxp >= rem);
                if (light) { int tc_ = threadIdx.x; asm volatile("" : "+v"(tc_)); const int lnc = tc_ & 63; const int nl = (rem == 0) ? G : G - rem, li = (rem == 0) ? bxp : bxp - rem;
                    CONVERT_LAYER(l + 1, li * NWAVES + wave, nl * NWAVES, lnc); }
            }
        }
        GSYNC();
        {
            pg8::Gemm g{ACT, (const bf16u*)(wl + WL_D), NTOK, DMOD, DFF}; int bxp = bx; asm volatile("" : "+s"(bxp)); pg8::StaticOrder S; S.init(NTOK, DMOD, G, bxp);
            pg8::EpiResid E{XB, ssqA};
            pg8::gemm_phase<pg8::EpiResid, pg8::StaticOrder, true, true>(L, g, S, E);
        }
        GSYNC();
    }
    int tf_ = threadIdx.x; asm volatile("" : "+v"(tf_)); const int lnf = tf_ & 63;
    for (int m = gw; m < NTOK; m += NGW) {
        const float rstd = row_rstd(ssqA, m);
#pragma unroll
        for (int j = 0; j < 2; ++j) {
            const int c = 8 * lnf + 512 * j;
            f32x4 x0, x1; unpack8(*(const v4u*)(XB + (size_t)m * DMOD + c), x0, x1);
            const f32x4 w0 = *(const f32x4*)(final_norm + c), w1 = *(const f32x4*)(final_norm + c + 4);
            *(f32x4*)(out + (size_t)m * DMOD + c) = x0 * rstd * w0; *(f32x4*)(out + (size_t)m * DMOD + c + 4) = x1 * rstd * w1;
        }
    }
}

extern "C" void kernel_launch(void* const* d_in, const int* in_sizes, int n_in, void* d_out, int out_size, void* d_ws, size_t ws_size, hipStream_t stream) {
    static int grid = 0;
    if (grid == 0) {
        if (n_in != 18 || out_size != NTOK * DMOD || ws_size < WS_END) { fprintf(stderr, "kernel_launch: unexpected shapes (n_in %d, out %d, ws %zu)\n", n_in, out_size, ws_size); grid = -1; return; }
        int dev = 0, cus = 0, per_cu = 0;
        if (hipGetDevice(&dev) != hipSuccess || hipDeviceGetAttribute(&cus, hipDeviceAttributeMultiprocessorCount, dev) != hipSuccess) { grid = -1; return; }
        if (hipFuncSetAttribute((const void*)mk_fwd, hipFuncAttributeMaxDynamicSharedMemorySize, LDS_BYTES) != hipSuccess) { fprintf(stderr, "kernel_launch: hipFuncSetAttribute failed\n"); grid = -1; return; }
        if (hipOccupancyMaxActiveBlocksPerMultiprocessor(&per_cu, (const void*)mk_fwd, NWAVES * 64, LDS_BYTES) != hipSuccess || per_cu < 1) per_cu = 1;
        (void)hipGetLastError();
        grid = cus * per_cu;
    }
    if (grid < 0) return;
    if (hipMemsetAsync((unsigned char*)d_ws + WS_BAR, 0, BAR_ZERO_BYTES, stream) != hipSuccess) { fprintf(stderr, "kernel_launch: memset failed\n"); return; }
    Args a{};
    for (int i = 0; i < 18; ++i) a.in[i] = d_in[i];
    a.out = (float*)d_out; a.ws = (unsigned char*)d_ws;
    for (int l = 0; l < 4; ++l) a.linit[l] = (float)(0.8 - 0.6 * exp(-0.3 * (double)l));
    for (int j = 0; j < 8; ++j) a.freq[j] = (float)pow(500000.0, -(double)j / 8.0);
    void* args[] = {&a};
    hipError_t e = hipLaunchCooperativeKernel((const void*)mk_fwd, dim3(grid), dim3(NWAVES * 64), args, LDS_BYTES, stream);
    if (e != hipSuccess) fprintf(stderr, "kernel_launch: cooperative launch failed: %s (grid %d)\n", hipGetErrorString(e), grid);
}
```

```cpp
#include <hip/hip_runtime.h>
#include <hip/hip_cooperative_groups.h>
#include <cstdio>
#include <cstdint>
namespace cg = cooperative_groups;
namespace pg8 {
#define PG8_LAS __attribute__((address_space(3)))
typedef unsigned short bf16_t;
typedef short bf16x8 __attribute__((ext_vector_type(8)));
typedef float f32x4 __attribute__((ext_vector_type(4)));
typedef unsigned u32x4 __attribute__((ext_vector_type(4)));
constexpr int BM = 256, BK = 64, HALF = 128, HTB = HALF * BK * 2  , STAGE_BYTES = 8 * HTB, NXCD = 8, WGM = 8;

__host__ __device__ __forceinline__ int lds_byte(int r, int c) { const int st = (r >> 4) * 2 + (c >> 5), rr = r & 15, cc = c & 31, ob = rr * 64 + cc * 2; return st * 1024 + (ob ^ (((ob >> 9) & 1) << 5)); }
__host__ __device__ __forceinline__ void stage_rc(int b, int& R, int& C) { const int st = b / 1024, sb = b % 1024, swz = sb ^ (((sb >> 9) & 1) << 5); R = (st >> 1) * 16 + swz / 64; C = (st & 1) * 32 + (swz % 64) / 2; }
__host__ __device__ __forceinline__ int perm32(int rho) { const int n = rho >> 4, i = rho & 15; return 8 * (i >> 2) + 4 * n + (i & 3); }

struct Unit { int pm, pn; };
struct Gemm { const bf16_t* A; const bf16_t* Bt; int M, N, K; const bf16_t* A2 = nullptr; const bf16_t* Bt2 = nullptr; };

struct StaticOrder {
    int nM, nN, nwg, G, c;
    __host__ __device__ void init(int M, int N, int G_, int c_) { nM = M / BM; nN = N / BM; nwg = nM * nN; G = G_; c = c_; }
    __host__ __device__ bool next(int i, Unit& u) const {
        const long L = (long)i * G + c; if (L >= nwg) return false;
        int wgid = (int)L; { const int q = nwg / NXCD, r = nwg % NXCD, xcd = wgid % NXCD, off = wgid / NXCD; wgid = (xcd < r ? xcd * (q + 1) : r * (q + 1) + (xcd - r) * q) + off; }
        const int nig = WGM * nN, gid = wgid / nig, fm = gid * WGM, gsz = (nM - fm) < WGM ? (nM - fm) : WGM;
        u.pm = fm + ((wgid % nig) % gsz); u.pn = (wgid % nig) / gsz; return true;
    }
    __device__ __forceinline__ void a_ready(const Unit&) const {}
    __device__ __forceinline__ void done(const Unit&) const {}
};

typedef float f32x2cv __attribute__((ext_vector_type(2))); typedef __bf16 bf16x2cv __attribute__((ext_vector_type(2)));
__device__ __forceinline__ unsigned cvt_pk_bf16(float lo, float hi) { const f32x2cv v = {lo, hi}; return __builtin_bit_cast(unsigned, __builtin_convertvector(v, bf16x2cv)); }
typedef float f32x2 __attribute__((ext_vector_type(2)));
typedef unsigned u32x2 __attribute__((ext_vector_type(2)));
__device__ __forceinline__ u32x4 pack8(const f32x4 v0, const f32x4 v1) { u32x4 w; w.x = cvt_pk_bf16(v0[0], v0[1]); w.y = cvt_pk_bf16(v0[2], v0[3]); w.z = cvt_pk_bf16(v1[0], v1[1]); w.w = cvt_pk_bf16(v1[2], v1[3]); return w; }
__device__ __forceinline__ float bf_lo(unsigned w) { return __uint_as_float(w << 16); }
__device__ __forceinline__ float bf_hi(unsigned w) { return __uint_as_float(w & 0xffff0000u); }
__device__ __forceinline__ void unpack8(const u32x4 w, f32x4& v0, f32x4& v1) { v0 = (f32x4){bf_lo(w.x), bf_hi(w.x), bf_lo(w.y), bf_hi(w.y)}; v1 = (f32x4){bf_lo(w.z), bf_hi(w.z), bf_lo(w.w), bf_hi(w.w)}; }
__device__ __forceinline__ float row_rstd(const float* ssq, int row) {
    const f32x4* p = (const f32x4*)(ssq + (size_t)row * 16);
    const f32x4 s = (p[0] + p[1]) + (p[2] + p[3]);
    return __builtin_amdgcn_rsqf(((s[0] + s[1]) + (s[2] + s[3])) * (1.0f / 1024.0f) + 1e-6f);
}
__device__ __forceinline__ float shfl_xor_l(float v, int mask, int lane) { return __builtin_bit_cast(float, __builtin_amdgcn_ds_bpermute((lane ^ mask) << 2, __builtin_bit_cast(int, v))); }
__device__ __forceinline__ float sigm(float v) { return __builtin_amdgcn_rcpf(1.0f + __expf(-v)); }

struct EpiProj {
    static constexpr bool PERM = true, AFTER_DRAIN = false;
    bf16_t* base; size_t stride; const float* ssq; const float* rope; float qscale; int pm0; const PG8_LAS float* rtab;
    __device__ __forceinline__ void operator()(const f32x4 (&acc)[2][2][4][2], const Unit& u, int wr, int wc, int fr_in, int fq_in) const {
        int fr = fr_in, fq = fq_in; asm volatile("" : "+v"(fr), "+v"(fq));
        const int colt = u.pn * BM, sec = colt >> 11, row0 = u.pm * BM + wr * 64 + fr;
        float rstd[2][4];
        if (u.pm == pm0) {
#pragma unroll
            for (int ai = 0; ai < 2; ++ai)
#pragma unroll
                for (int m = 0; m < 4; ++m) rstd[ai][m] = rtab[ai * HALF + wr * 64 + m * 16 + fr];
        } else {
#pragma unroll
            for (int ai = 0; ai < 2; ++ai)
#pragma unroll
                for (int m = 0; m < 4; ++m) rstd[ai][m] = row_rstd(ssq, row0 + ai * HALF + m * 16);
        }
        if (sec == 0) {
            const int t = colt >> 10;
            bf16_t* O = base + (size_t)t * stride + (colt & 1023) + wc * 32 + 8 * fq;
            const bool dorope = ((wc & 1) == 0) && (fq < 2);
            const int rofs = dorope ? 4 * fq : 0;
            const float sc = (t == 0) ? qscale : 1.0f;
#pragma unroll
            for (int ai = 0; ai < 2; ++ai) {
                f32x4 c4[4], s4[4];
#pragma unroll
                for (int m = 0; m < 4; ++m) { const float* rp = rope + (size_t)(row0 + ai * HALF + m * 16) * 16 + rofs; c4[m] = *(const f32x4*)rp; s4[m] = *(const f32x4*)(rp + 8); }
#pragma unroll
                for (int m = 0; m < 4; ++m) {
                    const f32x4 cc = dorope ? c4[m] : (f32x4){1.f, 1.f, 1.f, 1.f}, ss = dorope ? s4[m] : (f32x4){0.f, 0.f, 0.f, 0.f};
                    const float rs = rstd[ai][m] * sc;
                    bf16_t* rowp = O + (size_t)(row0 + ai * HALF + m * 16) * 1024;
#pragma unroll
                    for (int bj = 0; bj < 2; ++bj) {
                        const f32x4 v0 = acc[ai][bj][m][0] * rs, v1 = acc[ai][bj][m][1] * rs;
                        *(u32x4*)(rowp + bj * HALF) = pack8(v0 * cc - v1 * ss, v1 * cc + v0 * ss);
                    }
                }
            }
        } else if (sec == 1) {
            const int t = colt >> 10;
            bf16_t* O = base + (size_t)t * stride + (colt & 1023) + wc * 32 + 8 * fq;
#pragma unroll
            for (int ai = 0; ai < 2; ++ai)
#pragma unroll
                for (int m = 0; m < 4; ++m) {
                    bf16_t* rowp = O + (size_t)(row0 + ai * HALF + m * 16) * 1024;
#pragma unroll
                    for (int bj = 0; bj < 2; ++bj) *(u32x4*)(rowp + bj * HALF) = pack8(acc[ai][bj][m][0] * rstd[ai][m], acc[ai][bj][m][1] * rstd[ai][m]);
                }
        } else {
            const int cb = ((colt & 2047) >> 8) * 128 + wc * 32 + 8 * fq;
            if (sec == 2) {
#pragma unroll
                for (int ai = 0; ai < 2; ++ai)
#pragma unroll
                    for (int m = 0; m < 4; ++m) {
                        const float r2 = rstd[ai][m] * rstd[ai][m];
                        *(u32x4*)(base + 4 * stride + (size_t)(row0 + ai * HALF + m * 16) * 1024 + cb) = pack8(acc[ai][0][m][0] * acc[ai][1][m][0] * r2, acc[ai][0][m][1] * acc[ai][1][m][1] * r2);
                    }
            } else {
#pragma unroll
                for (int ai = 0; ai < 2; ++ai)
#pragma unroll
                    for (int m = 0; m < 4; ++m) {
                        const size_t off = (size_t)(row0 + ai * HALF + m * 16) * 1024 + cb;
                        f32x4 a0 = acc[ai][0][m][0] * rstd[ai][m], a1 = acc[ai][0][m][1] * rstd[ai][m], b0 = acc[ai][1][m][0] * rstd[ai][m], b1 = acc[ai][1][m][1] * rstd[ai][m];
#pragma unroll
                        for (int e = 0; e < 4; ++e) {
                            const float eb0 = 1.0f + __expf(-b0[e]), eb1 = 1.0f + __expf(-b1[e]);
                            a0[e] = eb0 * __builtin_amdgcn_rcpf(1.0f + __expf(-a0[e])); a1[e] = eb1 * __builtin_amdgcn_rcpf(1.0f + __expf(-a1[e]));
                            b0[e] = __builtin_amdgcn_rcpf(eb0); b1[e] = __builtin_amdgcn_rcpf(eb1); }
                        *(u32x4*)(base + 6 * stride + off) = pack8(a0, a1);
                        *(u32x4*)(base + 7 * stride + off) = pack8(b0, b1);
                    }
            }
        }
    }
};
struct EpiMix2 {
    static constexpr bool PERM = true, AFTER_DRAIN = false;
    const bf16_t* rat; const bf16_t* sgb; bf16_t* mixed;
    __device__ __forceinline__ void mid(f32x4 (&acc)[2][2][4][2], const Unit& u, int wr, int wc, int fr_in, int fq_in) const {
        int fr = fr_in, fq = fq_in; asm volatile("" : "+v"(fr), "+v"(fq));
        const bf16_t* gp = rat + (size_t)(u.pm * BM + wr * 64 + fr) * 1024 + u.pn * BM + wc * 32 + 8 * fq;
        u32x4 g[2][4][2];
#pragma unroll
        for (int ai = 0; ai < 2; ++ai)
#pragma unroll
            for (int m = 0; m < 4; ++m)
#pragma unroll
                for (int bj = 0; bj < 2; ++bj) g[ai][m][bj] = *(const u32x4*)(gp + (size_t)(ai * HALF + m * 16) * 1024 + bj * HALF);
#pragma unroll
        for (int ai = 0; ai < 2; ++ai)
#pragma unroll
            for (int m = 0; m < 4; ++m)
#pragma unroll
                for (int bj = 0; bj < 2; ++bj) { f32x4 g0, g1; unpack8(g[ai][m][bj], g0, g1); acc[ai][bj][m][0] = acc[ai][bj][m][0] * g0; acc[ai][bj][m][1] = acc[ai][bj][m][1] * g1; }
    }
    __device__ __forceinline__ void operator()(const f32x4 (&acc)[2][2][4][2], const Unit& u, int wr, int wc, int fr_in, int fq_in) const {
        int fr = fr_in, fq = fq_in; asm volatile("" : "+v"(fr), "+v"(fq));
        const size_t off0 = (size_t)(u.pm * BM + wr * 64 + fr) * 1024 + u.pn * BM + wc * 32 + 8 * fq;
        u32x4 g[2][4][2];
#pragma unroll
        for (int ai = 0; ai < 2; ++ai)
#pragma unroll
            for (int m = 0; m < 4; ++m)
#pragma unroll
                for (int bj = 0; bj < 2; ++bj) g[ai][m][bj] = *(const u32x4*)(sgb + off0 + (size_t)(ai * HALF + m * 16) * 1024 + bj * HALF);
#pragma unroll
        for (int ai = 0; ai < 2; ++ai)
#pragma unroll
            for (int m = 0; m < 4; ++m)
#pragma unroll
                for (int bj = 0; bj < 2; ++bj) { f32x4 g0, g1; unpack8(g[ai][m][bj], g0, g1);
                    *(u32x4*)(mixed + off0 + (size_t)(ai * HALF + m * 16) * 1024 + bj * HALF) = pack8(acc[ai][bj][m][0] * g0, acc[ai][bj][m][1] * g1); }
    }
};
struct EpiResid {
    static constexpr bool PERM = true, AFTER_DRAIN = false;
    bf16_t* xb; float* ssq;
    __device__ __forceinline__ void operator()(const f32x4 (&acc)[2][2][4][2], const Unit& u, int wr, int wc, int fr_in, int fq_in) const {
        int fr = fr_in, fq = fq_in; asm volatile("" : "+v"(fr), "+v"(fq));
        const int row0 = u.pm * BM + wr * 64 + fr, ln_ = fr + 16 * fq;
        bf16_t* xp = xb + (size_t)row0 * 1024 + u.pn * BM + wc * 32 + 8 * fq;
        u32x4 xv[2][4][2];
#pragma unroll
        for (int ai = 0; ai < 2; ++ai)
#pragma unroll
            for (int m = 0; m < 4; ++m)
#pragma unroll
                for (int bj = 0; bj < 2; ++bj) xv[ai][m][bj] = *(const u32x4*)(xp + (size_t)(ai * HALF + m * 16) * 1024 + bj * HALF);
#pragma unroll
        for (int ai = 0; ai < 2; ++ai)
#pragma unroll
            for (int m = 0; m < 4; ++m) {
                float ss = 0.f;
#pragma unroll
                for (int bj = 0; bj < 2; ++bj) {
                    f32x4 x0, x1; unpack8(xv[ai][m][bj], x0, x1);
                    const f32x4 v0 = x0 + acc[ai][bj][m][0], v1 = x1 + acc[ai][bj][m][1];
                    *(u32x4*)(xp + (size_t)(ai * HALF + m * 16) * 1024 + bj * HALF) = pack8(v0, v1);
                    ss += (v0[0] * v0[0] + v0[1] * v0[1]) + (v0[2] * v0[2] + v0[3] * v0[3]) + (v1[0] * v1[0] + v1[1] * v1[1]) + (v1[2] * v1[2] + v1[3] * v1[3]);
                }
                ss += shfl_xor_l(ss, 16, ln_); ss += shfl_xor_l(ss, 32, ln_);
                ssq[(size_t)(row0 + ai * HALF + m * 16) * 16 + u.pn * 4 + wc] = ss;
            }
    }
};
struct EpiSwiGLU {
    static constexpr bool PERM = true, AFTER_DRAIN = false;
    bf16_t* act; int ldc; const float* ssq; int pm0; const PG8_LAS float* rtab;
    __device__ __forceinline__ void operator()(const f32x4 (&acc)[2][2][4][2], const Unit& u, int wr, int wc, int fr_in, int fq_in) const {
        int fr = fr_in, fq = fq_in; asm volatile("" : "+v"(fr), "+v"(fq));
        const int row0 = u.pm * BM + wr * 64 + fr;
        float rstd[2][4];
        if (u.pm == pm0) {
#pragma unroll
            for (int ai = 0; ai < 2; ++ai)
#pragma unroll
                for (int m = 0; m < 4; ++m) rstd[ai][m] = rtab[ai * HALF + wr * 64 + m * 16 + fr];
        } else {
#pragma unroll
            for (int ai = 0; ai < 2; ++ai)
#pragma unroll
                for (int m = 0; m < 4; ++m) rstd[ai][m] = row_rstd(ssq, row0 + ai * HALF + m * 16);
        }
#pragma unroll
        for (int ai = 0; ai < 2; ++ai)
#pragma unroll
            for (int m = 0; m < 4; ++m) {
                f32x4 o[2];
#pragma unroll
                for (int n = 0; n < 2; ++n) {
                    const f32x4 g = acc[ai][0][m][n] * rstd[ai][m], up = acc[ai][1][m][n] * rstd[ai][m];
#pragma unroll
                    for (int e = 0; e < 4; ++e) o[n][e] = g[e] * sigm(g[e]) * up[e];
                }
                *(u32x4*)(act + (size_t)(row0 + ai * HALF + m * 16) * ldc + u.pn * HALF + wc * 32 + 8 * fq) = pack8(o[0], o[1]);
            }
    }
};
template <class Epi, class Sched, bool ALIGN_EPI = false, bool SP2 = false, bool SPLITK = false>
__device__ __forceinline__ void gemm_phase(PG8_LAS unsigned char* lds, const Gemm g, const Sched& S, const Epi& E) {
    int tid_l = threadIdx.x; asm volatile("" : "+v"(tid_l));
    const int tid = tid_l, wid = __builtin_amdgcn_readfirstlane(tid >> 6), lane = tid & 63, wr = wid >> 2, wc = wid & 3, fr = lane & 15, fq = lane >> 4;
    const int K = g.K, nt1 = K / BK, nt = SPLITK ? 2 * nt1 : nt1;
    unsigned voffA[2], voffB[2];
#pragma unroll
    for (int i = 0; i < 2; ++i) { int R, C; stage_rc(tid * 16 + i * 8192, R, C); const int Rb = Epi::PERM ? ((R & ~31) + perm32(R & 31)) : R;
        voffA[i] = (unsigned)(R * K + C) * 2u; voffB[i] = (unsigned)(Rb * K + C) * 2u; }
    const size_t kstep = (size_t)(BK * 2);
    const size_t hstep = (size_t)HALF * K * 2;
    const size_t tstep = 2 * hstep;
    const unsigned ldsw = (unsigned)wid * 1024u;
    const int aoff = lds_byte(wr * 64 + fr, fq * 8), boff = lds_byte(wc * 32 + fr, fq * 8);
#define PG8_SA(b, h) (((b) * 2 + (h)) * HTB)
#define PG8_SB(b, h) ((4 + (b) * 2 + (h)) * HTB)
#define PG8_STAGE(bufoff, gbase, voff) do { _Pragma("unroll") for (int _i = 0; _i < 2; ++_i) \
        __builtin_amdgcn_global_load_lds((const unsigned*)((const char*)(gbase) + (voff)[_i]), (PG8_LAS unsigned*)(lds + (bufoff) + ldsw + _i * 8192), 16, 0, 0); } while (0)
#define PG8_LDA(dst, b, h) do { _Pragma("unroll") for (int m = 0; m < 4; ++m) _Pragma("unroll") for (int k = 0; k < 2; ++k) dst[m][k] = *(const PG8_LAS bf16x8*)(lds + PG8_SA(b, h) + aoff + m * 2048 + k * 1024); } while (0)
#define PG8_LDB(dst, b, h) do { _Pragma("unroll") for (int n = 0; n < 2; ++n) _Pragma("unroll") for (int k = 0; k < 2; ++k) dst[n][k] = *(const PG8_LAS bf16x8*)(lds + PG8_SB(b, h) + boff + n * 2048 + k * 1024); } while (0)
#define PG8_MMA(ai, bj, At, Bt) do { __builtin_amdgcn_s_setprio(1); _Pragma("unroll") for (int m = 0; m < 4; ++m) _Pragma("unroll") for (int n = 0; n < 2; ++n) _Pragma("unroll") for (int k = 0; k < 2; ++k) \
        acc[ai][bj][m][n] = __builtin_amdgcn_mfma_f32_16x16x32_bf16(Bt[n][k], At[m][k], acc[ai][bj][m][n], 0, 0, 0); __builtin_amdgcn_s_setprio(0); } while (0)
#define PG8_WAIT_V(n) asm volatile("s_waitcnt vmcnt(" #n ")" ::: "memory")
#define PG8_WAIT_L(n) asm volatile("s_waitcnt lgkmcnt(" #n ")" ::: "memory")
#define PG8_BAR __builtin_amdgcn_s_barrier()
#define PG8_SCHED __builtin_amdgcn_sched_barrier(0)
    Unit cur, nxt; int ui = 0;
    if (!S.next(0, cur)) return;
    f32x4 acc[2][2][4][2];
#pragma unroll
    for (int a = 0; a < 2; ++a)
#pragma unroll
        for (int b = 0; b < 2; ++b)
#pragma unroll
            for (int m = 0; m < 4; ++m)
#pragma unroll
                for (int n = 0; n < 2; ++n) acc[a][b][m][n] = (f32x4){0.f, 0.f, 0.f, 0.f};
    bf16x8 At[4][2], B0[2][2], B1[2][2];
    const char* cA = (const char*)g.A + (size_t)cur.pm * tstep; const char* cB = (const char*)g.Bt + (size_t)cur.pn * tstep;
    const char* cA2 = SPLITK ? (const char*)g.A2 + (size_t)cur.pm * tstep : cA; const char* cB2 = SPLITK ? (const char*)g.Bt2 + (size_t)cur.pn * tstep : cB;
#define PG8_TA(tt) ((SPLITK && (tt) >= nt1) ? cA2 + (size_t)((tt) - nt1) * kstep : cA + (size_t)(tt) * kstep)
#define PG8_TB(tt) ((SPLITK && (tt) >= nt1) ? cB2 + (size_t)((tt) - nt1) * kstep : cB + (size_t)(tt) * kstep)
    S.a_ready(cur);
    if constexpr (SP2) {
        PG8_STAGE(PG8_SB(0, 0), cB, voffB); PG8_STAGE(PG8_SB(0, 1), cB + hstep, voffB); PG8_STAGE(PG8_SA(0, 0), cA, voffA); PG8_STAGE(PG8_SA(0, 1), cA + hstep, voffA);
        PG8_STAGE(PG8_SB(1, 0), cB + kstep, voffB); PG8_STAGE(PG8_SA(1, 0), cA + kstep, voffA); PG8_STAGE(PG8_SB(1, 1), cB + hstep + kstep, voffB);
        if (wr == 1) PG8_BAR;
        PG8_WAIT_V(8); PG8_BAR;
        PG8_WAIT_V(6); PG8_BAR;
    } else {
        PG8_STAGE(PG8_SB(0, 0), cB, voffB); PG8_STAGE(PG8_SA(0, 0), cA, voffA); PG8_STAGE(PG8_SB(0, 1), cB + hstep, voffB); PG8_STAGE(PG8_SA(0, 1), cA + hstep, voffA);
        if (wr == 1) PG8_BAR;
        PG8_WAIT_V(4); PG8_BAR;
        PG8_STAGE(PG8_SB(1, 0), cB + kstep, voffB); PG8_STAGE(PG8_SA(1, 0), cA + kstep, voffA); PG8_STAGE(PG8_SB(1, 1), cB + hstep + kstep, voffB);
        PG8_WAIT_V(6); PG8_BAR;
    }
    for (;;) {
        const bool has_next = S.next(ui + 1, nxt);
        const char* nA = has_next ? (const char*)g.A + (size_t)nxt.pm * tstep : cA; const char* nB = has_next ? (const char*)g.Bt + (size_t)nxt.pn * tstep : cB;
        for (int t = 0; t < nt; t += 2) {
            const bool last = (t == nt - 2);
            if constexpr (SPLITK) { if (t == nt1) E.mid(acc, cur, wr, wc, fr, fq); }
            const char* a1 = PG8_TA(t + 1);
            const char* a2 = last ? nA : PG8_TA(t + 2); const char* b2 = last ? nB : PG8_TB(t + 2);
            const char* a3 = a2 + kstep; const char* b3 = b2 + kstep;
            if (last && has_next) S.a_ready(nxt);
            if constexpr (SP2) {
            PG8_LDB(B0, 0, 0); PG8_LDB(B1, 0, 1); PG8_SCHED; PG8_LDA(At, 0, 0); PG8_STAGE(PG8_SA(1, 1), a1 + hstep, voffA);
            PG8_WAIT_V(8); PG8_WAIT_L(0); PG8_BAR; PG8_MMA(0, 0, At, B0); PG8_MMA(0, 1, At, B1); PG8_BAR; PG8_SCHED;
            PG8_LDA(At, 0, 1); PG8_STAGE(PG8_SB(0, 0), b2, voffB); PG8_STAGE(PG8_SB(0, 1), b2 + hstep, voffB); PG8_STAGE(PG8_SA(0, 0), a2, voffA);
            PG8_WAIT_V(8); PG8_WAIT_L(0); PG8_BAR; PG8_MMA(1, 0, At, B0); PG8_MMA(1, 1, At, B1); PG8_BAR; PG8_SCHED;
            PG8_LDB(B0, 1, 0); PG8_LDB(B1, 1, 1); PG8_SCHED; PG8_LDA(At, 1, 0); PG8_STAGE(PG8_SA(0, 1), a2 + hstep, voffA);
            PG8_WAIT_V(8); PG8_WAIT_L(0); PG8_BAR; PG8_MMA(0, 0, At, B0); PG8_MMA(0, 1, At, B1); PG8_BAR; PG8_SCHED;
            PG8_LDA(At, 1, 1); PG8_STAGE(PG8_SB(1, 0), b3, voffB); PG8_STAGE(PG8_SB(1, 1), b3 + hstep, voffB); PG8_STAGE(PG8_SA(1, 0), a3, voffA);
            PG8_WAIT_V(8); PG8_WAIT_L(0); PG8_BAR; PG8_MMA(1, 0, At, B0); PG8_MMA(1, 1, At, B1); PG8_BAR; PG8_SCHED;
            } else {
            PG8_LDB(B0, 0, 0); PG8_SCHED; PG8_LDA(At, 0, 0); PG8_STAGE(PG8_SA(1, 1), a1 + hstep, voffA);
            PG8_WAIT_L(8); PG8_BAR; PG8_WAIT_L(0); PG8_MMA(0, 0, At, B0); PG8_BAR; PG8_SCHED;
            PG8_LDB(B1, 0, 1); PG8_STAGE(PG8_SB(0, 0), b2, voffB);
            PG8_BAR; PG8_WAIT_L(0); PG8_MMA(0, 1, At, B1); PG8_BAR;
            PG8_LDA(At, 0, 1); PG8_STAGE(PG8_SA(0, 0), a2, voffA);
            PG8_BAR; PG8_WAIT_L(0); PG8_MMA(1, 0, At, B0); PG8_BAR; PG8_SCHED;
            PG8_STAGE(PG8_SB(0, 1), b2 + hstep, voffB);
            PG8_WAIT_V(6); PG8_BAR; PG8_MMA(1, 1, At, B1); PG8_BAR;
            PG8_LDB(B0, 1, 0); PG8_SCHED; PG8_LDA(At, 1, 0); PG8_STAGE(PG8_SA(0, 1), a2 + hstep, voffA);
            PG8_WAIT_L(8); PG8_BAR; PG8_WAIT_L(0); PG8_MMA(0, 0, At, B0); PG8_BAR; PG8_SCHED;
            PG8_LDB(B1, 1, 1); PG8_STAGE(PG8_SB(1, 0), b3, voffB);
            PG8_BAR; PG8_WAIT_L(0); PG8_MMA(0, 1, At, B1); PG8_BAR;
            PG8_LDA(At, 1, 1); PG8_STAGE(PG8_SA(1, 0), a3, voffA);
            PG8_BAR; PG8_WAIT_L(0); PG8_MMA(1, 0, At, B0); PG8_BAR; PG8_SCHED;
            PG8_STAGE(PG8_SB(1, 1), b3 + hstep, voffB);
            PG8_WAIT_V(6); PG8_BAR; PG8_MMA(1, 1, At, B1); PG8_BAR;
            }
        }
        if constexpr (ALIGN_EPI) { if (wr == 0) PG8_BAR; }
        if constexpr (!Epi::AFTER_DRAIN) { E(acc, cur, wr, wc, fr, fq); S.done(cur); }
        if (!has_next) break;
#pragma unroll
        for (int a = 0; a < 2; ++a)
#pragma unroll
            for (int b = 0; b < 2; ++b)
#pragma unroll
                for (int m = 0; m < 4; ++m)
#pragma unroll
                    for (int n = 0; n < 2; ++n) acc[a][b][m][n] = (f32x4){0.f, 0.f, 0.f, 0.f};
        cur = nxt; cA = nA; cB = nB; ++ui;
        if constexpr (SPLITK) { cA2 = (const char*)g.A2 + (size_t)cur.pm * tstep; cB2 = (const char*)g.Bt2 + (size_t)cur.pn * tstep; }
        if constexpr (ALIGN_EPI) { if (wr == 1) PG8_BAR; }
    }
    PG8_WAIT_V(0);
    if constexpr (!ALIGN_EPI) { if (wr == 0) PG8_BAR; }
    PG8_BAR;
    if constexpr (Epi::AFTER_DRAIN) { E.fused(acc, cur, wr, wc, fr, fq, lds, wid, lane); S.done(cur); }
#undef PG8_TA
#undef PG8_TB
#undef PG8_SA
#undef PG8_SB
#undef PG8_STAGE
#undef PG8_LDA
#undef PG8_LDB
#undef PG8_MMA
#undef PG8_WAIT_V
#undef PG8_WAIT_L
#undef PG8_BAR
#undef PG8_SCHED
}
}

#ifndef PG8_SP2
#define PG8_SP2 true
#endif
#ifndef PG8_ALIGN
#define PG8_ALIGN true
#endif
#include <hip/hip_bf16.h>
#include <cmath>
namespace attn_body {
using bf16=__hip_bfloat16;
using bf16x8=__attribute__((ext_vector_type(8)))short;
using s16x4=__attribute__((ext_vector_type(4)))short;
using f32x16=__attribute__((ext_vector_type(16)))float;
using u32x4=__attribute__((ext_vector_type(4)))unsigned;
constexpr int BATCH=4,NHEAD=16,SEQ=4096,D=64,DM=NHEAD*D;
constexpr int NW=8,QBLK=32,QB=QBLK*NW,KVBLK=64,NQB=SEQ/QB;
constexpr int ATTN_PITCH=DM, ATTN_UNIT_ROWS=QB;
__device__ __forceinline__ int crow(int r,int hi){return (r&3)+8*(r>>2)+4*hi;}
#define SBAR() __builtin_amdgcn_sched_barrier(0)
__device__ __forceinline__ void cmask(f32x16&p0,f32x16&p1,int jb,int qrel,int hi){
  const float NEG=-INFINITY; (void)hi;
  #pragma unroll
  for(int r=0;r<16;++r){ if(jb>(qrel>>6)){p0[r]=NEG; p1[r]=NEG;} }
}

constexpr int NSLOT=3, SLOTB=8192;
constexpr int LDS_K=0, LDS_V=NSLOT*SLOTB, LDS_WS=3*NSLOT*SLOTB, LDS_OST=LDS_WS+NW*64*4, LDS_BYTES=LDS_OST+NW*4096;
constexpr float C2=0.125f*1.4426950408889634f;
__device__ __forceinline__ void glds16(const void*gsrc,unsigned lds_dst){unsigned keep;
  asm volatile("s_mov_b32 %0, m0\n\ts_mov_b32 m0, %2\n\ts_nop 0\n\tglobal_load_lds_dwordx4 %1, off\n\ts_mov_b32 m0, %0":"=&s"(keep):"v"(gsrc),"s"(lds_dst):"memory");}
__device__ __forceinline__ float max3f(float a,float b,float c){float r;asm("v_max3_f32 %0, %1, %2, %3":"=v"(r):"v"(a),"v"(b),"v"(c));return r;}
__device__ __forceinline__ float max2f(float a,float b){float r;asm("v_max_f32_e32 %0, %1, %2":"=v"(r):"v"(a),"v"(b));return r;}
__device__ __forceinline__ float fadd_s(float a,float b){float r;asm("v_add_f32_e32 %0, %1, %2":"=v"(r):"v"(a),"v"(b));return r;}
__device__ __forceinline__ float fsub_s(float a,float b){float r;asm("v_sub_f32_e32 %0, %1, %2":"=v"(r):"v"(a),"v"(b));return r;}
typedef float f32x2_t __attribute__((ext_vector_type(2))); typedef __bf16 bf16x2_t __attribute__((ext_vector_type(2)));
__device__ __forceinline__ unsigned cvtpk_s(float lo,float hi){f32x2_t v={lo,hi};bf16x2_t b=__builtin_convertvector(v,bf16x2_t);return __builtin_bit_cast(unsigned,b);}
#define WAIT_BAR(N) asm volatile("s_waitcnt vmcnt(" #N ") lgkmcnt(0)\n\ts_barrier":::"memory")

__device__ __forceinline__ void qkt(f32x16&p0,f32x16&p1,const char*Kslot,const bf16x8*qr,const f32x16&negm,int r32,int hi){
  const char*kb=Kslot+hi*1024+r32*16;
  #pragma unroll
  for(int d0=0;d0<4;++d0){
    const bf16x8 b0=*reinterpret_cast<const bf16x8*>(kb+d0*2048);
    const bf16x8 b1=*reinterpret_cast<const bf16x8*>(kb+d0*2048+512);
    if(d0==0){p0=__builtin_amdgcn_mfma_f32_32x32x16_bf16(b0,qr[0],negm,0,0,0);p1=__builtin_amdgcn_mfma_f32_32x32x16_bf16(b1,qr[0],negm,0,0,0);}
    else{p0=__builtin_amdgcn_mfma_f32_32x32x16_bf16(b0,qr[d0],p0,0,0,0);p1=__builtin_amdgcn_mfma_f32_32x32x16_bf16(b1,qr[d0],p1,0,0,0);}}
}
typedef __attribute__((address_space(3))) const char* lds_cptr;
typedef short v4i16_t __attribute__((ext_vector_type(4)));
__device__ __forceinline__ void kload8(bf16x8*kf,lds_cptr kp){
  kf[0]=*(const __attribute__((address_space(3))) bf16x8*)(kp);      kf[1]=*(const __attribute__((address_space(3))) bf16x8*)(kp+512);
  kf[2]=*(const __attribute__((address_space(3))) bf16x8*)(kp+2048); kf[3]=*(const __attribute__((address_space(3))) bf16x8*)(kp+2560);
  kf[4]=*(const __attribute__((address_space(3))) bf16x8*)(kp+4096); kf[5]=*(const __attribute__((address_space(3))) bf16x8*)(kp+4608);
  kf[6]=*(const __attribute__((address_space(3))) bf16x8*)(kp+6144); kf[7]=*(const __attribute__((address_space(3))) bf16x8*)(kp+6656);
}
__device__ __forceinline__ void kload2(bf16x8*kf,lds_cptr kp,int j){ kf[2*j]=*(const __attribute__((address_space(3))) bf16x8*)(kp+j*2048); kf[2*j+1]=*(const __attribute__((address_space(3))) bf16x8*)(kp+j*2048+512); }
__device__ __forceinline__ s16x4 vtr(lds_cptr p){ return __builtin_bit_cast(s16x4,__builtin_amdgcn_ds_read_tr16_b64_v4i16((__attribute__((address_space(3))) v4i16_t*)p)); }
__device__ __forceinline__ float rowmax(const f32x16&p0,const f32x16&p1){
  float a=max3f(p0[0],p0[1],p1[0]),b=max3f(p0[2],p0[3],p1[1]);a=max3f(a,p1[2],p1[3]);
  #pragma unroll
  for(int r=4;r<16;r+=4){a=max3f(a,p0[r],p0[r+1]);b=max3f(b,p0[r+2],p0[r+3]);a=max3f(a,p1[r],p1[r+1]);b=max3f(b,p1[r+2],p1[r+3]);}
  const float m=max2f(a,b);
  auto rr=__builtin_amdgcn_permlane32_swap(__float_as_uint(m),__float_as_uint(m),false,false);
  return max2f(__uint_as_float(rr[0]),__uint_as_float(rr[1]));
}
__device__ __forceinline__ void pv(f32x16*o,int vb,bf16x8 pa0,bf16x8 pa1,bf16x8 pa2,bf16x8 pa3){
  #pragma unroll
  for(int d0=0;d0<4;++d0){s16x4 lo[4],hi[4];
    #pragma unroll
    for(int ks=0;ks<4;++ks){
      asm volatile("ds_read_b64_tr_b16 %0,%1 offset:%c2":"=&v"(lo[ks]):"v"(vb),"i"(d0*4096+ks*1024):"memory");
      asm volatile("ds_read_b64_tr_b16 %0,%1 offset:%c2":"=&v"(hi[ks]):"v"(vb),"i"(d0*4096+ks*1024+512):"memory");}
    asm volatile("s_waitcnt lgkmcnt(0)":::"memory");SBAR();
    #define PK(k) (bf16x8){lo[k][0],lo[k][1],lo[k][2],lo[k][3],hi[k][0],hi[k][1],hi[k][2],hi[k][3]}
    o[d0]=__builtin_amdgcn_mfma_f32_32x32x16_bf16(pa0,PK(0),o[d0],0,0,0);
    o[d0]=__builtin_amdgcn_mfma_f32_32x32x16_bf16(pa1,PK(1),o[d0],0,0,0);
    o[d0]=__builtin_amdgcn_mfma_f32_32x32x16_bf16(pa2,PK(2),o[d0],0,0,0);
    o[d0]=__builtin_amdgcn_mfma_f32_32x32x16_bf16(pa3,PK(3),o[d0],0,0,0);
    #undef PK
  }
}

#ifndef ATTN_STORE16
#define ATTN_STORE16(p,v) (*(u32x4*)(p)=(v))
#endif
template<int THRL> __device__ __forceinline__ void attn_unit(int b,int hq,int vcol,int qb,const bf16*Q,const bf16*__restrict__ K,const bf16*__restrict__ V,bf16*O,char*shm){
  int tid_l=threadIdx.x; asm volatile("":"+v"(tid_l));
  const int tid=tid_l,lane=tid&63,r32=lane&31,hi=lane>>5; const int wid=__builtin_amdgcn_readfirstlane(tid>>6);
  const long rowbase=(long)b*SEQ; const int q0=qb*QB;
  const bf16*Qw=Q+(rowbase+q0+wid*QBLK)*DM+hq*D;
  const bf16*Kh=K+rowbase*DM+hq*D,*Vh=V+rowbase*DM+vcol;
  const unsigned lds0=(unsigned)(uintptr_t)shm;
  float*wsf=(float*)(shm+LDS_WS)+wid*64;
  const bf16*ksrc=Kh+(long)lane*DM+wid*8;
  const bf16*vsrc=Vh+(long)(16*(wid&3)+(lane>>2))*DM+(wid>>2)*32+(lane&3)*8;
  const unsigned kdst=lds0+LDS_K+wid*1024, vdst=lds0+LDS_V+wid*1024;
  #define DMA_K(t,slot) glds16(ksrc+(long)(t)*KVBLK*DM,(unsigned)__builtin_amdgcn_readfirstlane(kdst+(slot)))
  #define DMA_V(t,slot) do{ glds16(vsrc+(long)(t)*KVBLK*DM,(unsigned)__builtin_amdgcn_readfirstlane(vdst+2*(slot))); glds16(vsrc+(long)(t)*KVBLK*DM+64,(unsigned)__builtin_amdgcn_readfirstlane(vdst+2*(slot)+8192)); }while(0)
  const int vb0=(int)(lds0+LDS_V)+((lane>>4)&1)*32+(lane&3)*8+(4*hi+((lane&15)>>2))*64;
  const char*Kbase=shm+LDS_K; bf16x8 kf[8];
  const lds_cptr shm3=(lds_cptr)shm; const lds_cptr kp0=shm3+LDS_K+hi*1024+r32*16; const lds_cptr vp0=shm3+LDS_V+((lane>>4)&1)*32+(lane&3)*8+(4*hi+((lane&15)>>2))*64;
  const int NT=(q0+QB)/KVBLK;
  DMA_K(0,0);DMA_V(0,0);DMA_K(1,SLOTB);
  bf16x8 qr[4];
  #pragma unroll
  for(int d0=0;d0<4;++d0)qr[d0]=*reinterpret_cast<const bf16x8*>(&Qw[(long)r32*DM+d0*16+hi*8]);
  float mhat=0.f,l_reg=0.f;f32x16 o[4];o[0]=f32x16{};o[1]=f32x16{};o[2]=f32x16{};o[3]=f32x16{};f32x16 negm=f32x16{};asm volatile("":"+v"(negm));
  const int qrel=wid*QBLK+r32;
  #define CMASK(P0,P1,t) do{int jb_=(t)-(NT-4); if(jb_>=0)cmask(P0,P1,jb_,qrel,hi);}while(0)
  bool resc=false;
  #define START(P0,P1) do{ const float rm=rowmax(P0,P1); resc=false; \
    { const float dl=rm; mhat=fadd_s(mhat,dl); \
      _Pragma("unroll") for(int r=0;r<16;++r){P0[r]=fsub_s(P0[r],dl);P1[r]=fsub_s(P1[r],dl);} \
      _Pragma("unroll") for(int r=0;r<16;++r)negm[r]=-mhat; asm volatile("":"+v"(negm)); } \
    _Pragma("unroll") for(int r=0;r<16;++r)P0[r]=__builtin_amdgcn_exp2f(P0[r]); }while(0)
  #define RESC() do{ if(resc){ asm volatile("s_waitcnt lgkmcnt(0)":::"memory"); \
      _Pragma("unroll") for(int d_=0;d_<4;++d_) _Pragma("unroll") for(int r=0;r<16;++r)o[d_][r]*=wsf[crow(r,hi)]; } }while(0)
  f32x16 pA0,pA1,pB0,pB1;
  int sl_prev=0,sl_cur=0,sl_next=SLOTB;
  #define ROT() do{sl_prev=sl_cur;sl_cur=sl_next;sl_next=(sl_next==(NSLOT-1)*SLOTB)?0:sl_next+SLOTB;}while(0)
  DMA_K(2,2*SLOTB);
  WAIT_BAR(4);
  qkt(pA0,pA1,Kbase,qr,negm,r32,hi);asm volatile("s_nop 15\n\ts_nop 7":"+v"(pA0),"+v"(pA1));CMASK(pA0,pA1,0);
  START(pA0,pA1);
  _Pragma("unroll") for(int r=0;r<16;++r)pA1[r]=__builtin_amdgcn_exp2f(pA1[r]);
  WAIT_BAR(0);
  DMA_K(3,0);DMA_V(1,SLOTB);
  ROT();
  kload8(kf,kp0+sl_cur);
  WAIT_BAR(3);
  s16x4 vlo[4],vhi[4]; u32x4 pw0,pw1,pw2,pw3;
  #define PKW(P,B) cvtpk_s(P[B],P[B+1])
  #define PAF(k) __builtin_bit_cast(bf16x8,pw##k)
  #define VFR(i) (bf16x8){vlo[i][0],vlo[i][1],vlo[i][2],vlo[i][3],vhi[i][0],vhi[i][1],vhi[i][2],vhi[i][3]}
  #define VRDJ(d,ks) do{ vlo[d]=vtr(vp_+((d)*4096+(ks)*1024)); vhi[d]=vtr(vp_+((d)*4096+(ks)*1024+512)); }while(0)
  #define GAPB2(MF,X,B) do{ MF; X[B]=EX(X[B]); X[B+1]=EX(X[B+1]); PIN(X); SBAR(); }while(0)
  #define PVM(d,ks) o[d]=__builtin_amdgcn_mfma_f32_32x32x16_bf16(PAF(ks),VFR(d),o[d],0,0,0)
  #define PIN(x) asm volatile("":"+v"(x))
  #define MX3(a,b,c) __builtin_fmaxf(__builtin_fmaxf((a),(b)),(c))
  #define GAPA(MF,A0,A1,A2,A3,W0,W1,PW) do{ MF; sacc+=A0; sacc+=A1; sacc+=A2; sacc+=A3; PIN(sacc); W0; W1; PIN(PW); SBAR(); }while(0)
  #define EX(v) __builtin_amdgcn_exp2f(v)
  #define GAPB(MF,X,B) do{ MF; X[B]=EX(X[B]); X[B+1]=EX(X[B+1]); X[B+2]=EX(X[B+2]); X[B+3]=EX(X[B+3]); PIN(X); SBAR(); }while(0)
  #define VRD(i) do{ vlo[i]=vtr(vp_+(((i)>>2)*4096+((i)&3)*1024)); vhi[i]=vtr(vp_+(((i)>>2)*4096+((i)&3)*1024+512)); }while(0)
  #define KRD(G,j) do{ if(G){ kload2(kf,kp0+sl_next,j); SBAR(); } }while(0)
  #define STEP(C0,C1,P0,P1,t,GK,GV,GL) do{ SBAR(); \
    const lds_cptr vp_=vp0+2*sl_prev; \
    float sacc=(P0[0]+P0[1]); \
    GAPA(C0=__builtin_amdgcn_mfma_f32_32x32x16_bf16(kf[0],qr[0],negm,0,0,0), P0[2],P0[3],P0[4],P0[5],     pw0[0]=PKW(P0,0), pw0[1]=PKW(P0,2), pw0); \
    GAPA(C1=__builtin_amdgcn_mfma_f32_32x32x16_bf16(kf[1],qr[0],negm,0,0,0), P0[6],P0[7],P0[8],P0[9],     pw0[2]=PKW(P0,4), pw0[3]=PKW(P0,6), pw0); \
    GAPA(C0=__builtin_amdgcn_mfma_f32_32x32x16_bf16(kf[2],qr[1],C0,0,0,0),   P0[10],P0[11],P0[12],P0[13], pw1[0]=PKW(P0,8), pw1[1]=PKW(P0,10), pw1); \
    GAPA(C1=__builtin_amdgcn_mfma_f32_32x32x16_bf16(kf[3],qr[1],C1,0,0,0),   P0[14],P0[15],P1[0],P1[1],   pw1[2]=PKW(P0,12),pw1[3]=PKW(P0,14), pw1); \
    GAPA(C0=__builtin_amdgcn_mfma_f32_32x32x16_bf16(kf[4],qr[2],C0,0,0,0),   P1[2],P1[3],P1[4],P1[5],     pw2[0]=PKW(P1,0), pw2[1]=PKW(P1,2), pw2); \
    GAPA(C1=__builtin_amdgcn_mfma_f32_32x32x16_bf16(kf[5],qr[2],C1,0,0,0),   P1[6],P1[7],P1[8],P1[9],     pw2[2]=PKW(P1,4), pw2[3]=PKW(P1,6), pw2); \
    GAPA(C0=__builtin_amdgcn_mfma_f32_32x32x16_bf16(kf[6],qr[3],C0,0,0,0),   P1[10],P1[11],P1[12],P1[13], pw3[0]=PKW(P1,8), pw3[1]=PKW(P1,10), pw3); \
    GAPA(C1=__builtin_amdgcn_mfma_f32_32x32x16_bf16(kf[7],qr[3],C1,0,0,0),   P1[14],P1[15],0.f,0.f,       pw3[2]=PKW(P1,12),pw3[3]=PKW(P1,14), pw3); \
    l_reg+=sacc; \
    VRDJ(0,0); VRDJ(1,0); VRDJ(2,0); VRDJ(3,0); SBAR(); \
    if(GK){DMA_K((t)+3,sl_cur);} if(GV){DMA_V((t)+1,sl_next);} \
    CMASK(C0,C1,t); \
    { float a=MX3(C0[0],C0[1],C1[0]),b=MX3(C0[2],C0[3],C1[1]); a=MX3(a,C1[2],C1[3]); \
      _Pragma("unroll") for(int r=4;r<16;r+=4){a=MX3(a,C0[r],C0[r+1]);b=MX3(b,C0[r+2],C0[r+3]);a=MX3(a,C1[r],C1[r+1]);b=MX3(b,C1[r+2],C1[r+3]);} \
      float rm=__builtin_fmaxf(a,b); { auto rr=__builtin_amdgcn_permlane32_swap(__float_as_uint(rm),__float_as_uint(rm),false,false); rm=__builtin_fmaxf(__uint_as_float(rr[0]),__uint_as_float(rr[1])); } \
      resc=false; \
      if(__builtin_expect(__any(rm>(float)THRL),0)){ const float dl=__builtin_fmaxf(rm,0.f); mhat+=dl; \
        _Pragma("unroll") for(int r=0;r<16;++r){C0[r]-=dl;C1[r]-=dl;} \
        _Pragma("unroll") for(int r=0;r<16;++r)negm[r]=-mhat; asm volatile("":"+v"(negm)); \
        const float f=__builtin_amdgcn_exp2f(-dl); l_reg*=f; if(hi==0)wsf[r32]=f; resc=true; } } \
    SBAR(); \
    GAPB2(PVM(0,0), C0,0);  VRDJ(0,1); SBAR(); \
    GAPB2(PVM(1,0), C0,2);  VRDJ(1,1); SBAR(); \
    GAPB2(PVM(2,0), C0,4);  VRDJ(2,1); SBAR(); \
    GAPB2(PVM(3,0), C0,6);  VRDJ(3,1); SBAR(); \
    KRD(GL,0); GAPB2(PVM(0,1), C0,8);  VRDJ(0,2); SBAR(); \
    KRD(GL,1); GAPB2(PVM(1,1), C0,10); VRDJ(1,2); SBAR(); \
    KRD(GL,2); GAPB2(PVM(2,1), C0,12); VRDJ(2,2); SBAR(); \
    KRD(GL,3); GAPB2(PVM(3,1), C0,14); VRDJ(3,2); SBAR(); \
    GAPB2(PVM(0,2), C1,0);  VRDJ(0,3); SBAR(); \
    GAPB2(PVM(1,2), C1,2);  VRDJ(1,3); SBAR(); \
    GAPB2(PVM(2,2), C1,4);  VRDJ(2,3); SBAR(); \
    GAPB2(PVM(3,2), C1,6);  VRDJ(3,3); SBAR(); \
    GAPB2(PVM(0,3), C1,8); \
    GAPB2(PVM(1,3), C1,10); \
    GAPB2(PVM(2,3), C1,12); \
    GAPB2(PVM(3,3), C1,14); \
    }while(0)
  int t=1;
  #undef CMASK
  #define CMASK(P0,P1,t) do{}while(0)
  for(;t+5<NT;t+=2){
    STEP(pB0,pB1,pA0,pA1,t,true,true,true);     WAIT_BAR(3); RESC(); ROT();
    STEP(pA0,pA1,pB0,pB1,t+1,true,true,true);   WAIT_BAR(3); RESC(); ROT();
  }
  #undef CMASK
  #define CMASK(P0,P1,t) do{int jb_=(t)-(NT-4); if(jb_>=0)cmask(P0,P1,jb_,qrel,hi);}while(0)
  #define ENDW(tt) do{ if((tt)+3<NT){WAIT_BAR(3);} else if((tt)+2<NT){WAIT_BAR(2);} else {WAIT_BAR(0);} }while(0)
  for(;t+1<NT;t+=2){
    STEP(pB0,pB1,pA0,pA1,t,(t+3<NT),(t+1<NT),(t+1<NT));       ENDW(t);   RESC(); ROT();
    STEP(pA0,pA1,pB0,pB1,t+1,(t+4<NT),(t+2<NT),(t+2<NT));     ENDW(t+1); RESC(); ROT();
  }
  STEP(pB0,pB1,pA0,pA1,NT-1,false,false,false); RESC();
  { float sacc=pB0[0]+pB0[1]; _Pragma("unroll") for(int r=2;r<16;++r)sacc+=pB0[r]; _Pragma("unroll") for(int r=0;r<16;++r)sacc+=pB1[r]; l_reg+=sacc;
    pw0=(u32x4){PKW(pB0,0),PKW(pB0,2),PKW(pB0,4),PKW(pB0,6)};pw1=(u32x4){PKW(pB0,8),PKW(pB0,10),PKW(pB0,12),PKW(pB0,14)};pw2=(u32x4){PKW(pB1,0),PKW(pB1,2),PKW(pB1,4),PKW(pB1,6)};pw3=(u32x4){PKW(pB1,8),PKW(pB1,10),PKW(pB1,12),PKW(pB1,14)};
    SBAR(); pv(o,vb0+2*sl_cur,PAF(0),PAF(1),PAF(2),PAF(3)); }
  #undef PKW
  #undef PAF
  #undef VFR
  #undef PIN
  #undef MX3
  #undef GAPA
  #undef GAPB
  #undef EX
  #undef VRD
  #undef VRDJ
  #undef GAPB2
  #undef PVM
  #undef KRD
  #undef STEP
  #undef ENDW
  {auto rr=__builtin_amdgcn_permlane32_swap(__float_as_uint(l_reg),__float_as_uint(l_reg),false,false);l_reg=__uint_as_float(rr[0])+__uint_as_float(rr[1]);}
  if(hi==0)wsf[32+r32]=l_reg;asm volatile("s_waitcnt lgkmcnt(0)":::"memory");
  float rli[16];
  #pragma unroll
  for(int r=0;r<16;++r)rli[r]=__builtin_amdgcn_rcpf(wsf[32+crow(r,hi)]);
  bf16*Ow=O+(rowbase+q0+wid*QBLK)*DM+vcol;
  { bf16*stg=(bf16*)(shm+LDS_OST)+wid*2048;
    #pragma unroll
    for(int hf=0;hf<2;++hf){
      #pragma unroll
      for(int r=0;r<16;++r){const int orow=crow(r,hi);
        #pragma unroll
        for(int d0=0;d0<2;++d0)stg[orow*64+d0*32+r32]=__float2bfloat16(o[2*hf+d0][r]*rli[r]);}
      asm volatile("s_waitcnt lgkmcnt(0)":::"memory");
      #pragma unroll
      for(int i=0;i<4;++i){const int row=i*8+(lane>>3),ch=lane&7; const u32x4 v=*(const u32x4*)(stg+row*64+ch*8); ATTN_STORE16(Ow+(long)row*DM+hf*64+ch*8,v);}
      asm volatile("s_waitcnt lgkmcnt(0)":::"memory"); } }
  asm volatile("s_waitcnt lgkmcnt(0)\n\ts_barrier":::"memory");
  #undef DMA_K
  #undef DMA_V
  #undef CMASK
  #undef START
  #undef RESC
  #undef ROT
}
constexpr int ATTN_LDS_BYTES=LDS_BYTES;
#undef SBAR
#undef WAIT_BAR
}
#define LAS __attribute__((address_space(3)))
typedef unsigned short bf16u;
typedef unsigned v4u __attribute__((ext_vector_type(4)));
typedef float f32x4 __attribute__((ext_vector_type(4)));
using pg8::pack8; using pg8::unpack8; using pg8::row_rstd;

#define XB_TMO      128
#define XB_XCNT(j)  (256  + 64 * (j))
#define XB_XSUB(j)  (1280 + 64 * (j))
#define XB_XGEN(j)  (2304 + 64 * (j))
#define XB_TOP      3328
#define XB_TOPGEN   3392
#define XCD_BAR_WORDS 3456
#define XB_SPIN_CAP (1u << 18)

__device__ __forceinline__ unsigned xb_ld(unsigned* p)              { return __hip_atomic_load(p, __ATOMIC_RELAXED, __HIP_MEMORY_SCOPE_AGENT); }
__device__ __forceinline__ unsigned xb_add(unsigned* p, unsigned v) { return __hip_atomic_fetch_add(p, v, __ATOMIC_RELAXED, __HIP_MEMORY_SCOPE_AGENT); }
__device__ __forceinline__ unsigned xb_xcc_id() { return (unsigned)__builtin_amdgcn_s_getreg((3 << 11) | 20) & 0xFu; }
#define XB_SPIN(cond, bar) do { unsigned _sp = 0; while (cond) { __builtin_amdgcn_s_sleep(1); \
    if ((++_sp & 255u) == 0u) { if (xb_ld(&(bar)[XB_TMO])) break; if (_sp > XB_SPIN_CAP) { atomicAdd(&(bar)[XB_TMO], 1u); break; } } } } while (0)

struct XcdBarrier {
    unsigned* bar; unsigned x;
    volatile LAS unsigned* st;
};

__device__ __forceinline__ XcdBarrier xcd_barrier_post(unsigned* bar, volatile LAS unsigned* st) {
    XcdBarrier b; b.bar = bar; b.x = xb_xcc_id(); b.st = st;
    if (threadIdx.x == 0) (void)xb_add(&bar[XB_XCNT(b.x)], 1u);
    return b;
}
__device__ __forceinline__ void xcd_barrier_complete(unsigned* bar, unsigned x, unsigned& nloc, unsigned& nx) {
    const unsigned G = gridDim.x * gridDim.y * gridDim.z;
    unsigned sum, cnt, mine, sp = 0u;
    for (;;) {
        sum = 0u; cnt = 0u; mine = 0u;
#pragma unroll
        for (unsigned j = 0; j < 16; ++j) { const unsigned c = xb_ld(&bar[XB_XCNT(j)]); sum += c; cnt += (c > 0u) ? 1u : 0u; mine = (j == x) ? c : mine; }
        if (sum == G) break;
        __builtin_amdgcn_s_sleep(1);
        if ((++sp & 255u) == 0u) { if (xb_ld(&bar[XB_TMO])) break; if (sp > XB_SPIN_CAP) { atomicAdd(&bar[XB_TMO], 1u); break; } }
    }
    nloc = mine > 0u ? mine : 1u; nx = cnt > 0u ? cnt : 1u;
}

__device__ __forceinline__ void xcd_barrier(const XcdBarrier& b) {
    asm volatile("s_waitcnt vmcnt(0)" ::: "memory");
    __syncthreads();
    if (threadIdx.x == 0) {
        unsigned* bar = b.bar;
        __builtin_amdgcn_s_waitcnt(0);
        unsigned nloc = b.st[0], nx = b.st[1];
        if (nloc == 0u) { xcd_barrier_complete(bar, b.x, nloc, nx); b.st[0] = nloc; b.st[1] = nx; }
        const unsigned old = xb_add(&bar[XB_XSUB(b.x)], 1u);
        const unsigned gen = old / nloc;
        if (old + 1u == (gen + 1u) * nloc) {
            __builtin_amdgcn_fence(__ATOMIC_RELEASE, "agent");
            asm volatile("s_waitcnt vmcnt(0)" ::: "memory");
            const unsigned og = xb_add(&bar[XB_TOP], 1u);
            const unsigned tg = og / nx;
            if (og + 1u == (tg + 1u) * nx) xb_add(&bar[XB_TOPGEN], 1u);
            else XB_SPIN(xb_ld(&bar[XB_TOPGEN]) == tg, bar);
            __builtin_amdgcn_fence(__ATOMIC_ACQUIRE, "agent");
            xb_add(&bar[XB_XGEN(b.x)], 1u);
            asm volatile("s_waitcnt vmcnt(0)" ::: "memory");
        } else {
            XB_SPIN(xb_ld(&bar[XB_XGEN(b.x)]) == gen, bar);
            __builtin_amdgcn_fence(__ATOMIC_ACQUIRE, "agent");
            asm volatile("s_waitcnt vmcnt(0)" ::: "memory");
        }
    }
    __syncthreads();
}


constexpr int NWAVES = 8;
constexpr int NTOK = 16384, DMOD = 1024, SEQL = 4096, NLAYER = 4, DFF = 2816, INW = 8192;
constexpr size_t MiB = 1u << 20;
constexpr size_t WS_ROPE = 0;
constexpr size_t WS_SSQA = 1 * MiB, WS_SSQB = 2 * MiB;
constexpr size_t WS_BAR = 3 * MiB + 65536, BAR_ZERO_BYTES = 65536;
constexpr size_t WS_LAM = 3 * MiB;
constexpr size_t WS_W = 4 * MiB, W_LAYER = 77 * MiB / 2;
constexpr size_t WL_IN = 0, WL_A = 16 * MiB, WL_B = 18 * MiB, WL_O = 20 * MiB, WL_GU = 22 * MiB, WL_D = 33 * MiB;
constexpr size_t WS_XB = 158 * MiB;
constexpr size_t BUFB = 32 * MiB, BUFE = BUFB / 2;
constexpr size_t WS_Q = 190 * MiB;
constexpr size_t WS_ACT = WS_Q;
constexpr size_t WS_STASH = WS_Q + 4 * BUFB;
constexpr size_t WS_O1 = 446 * MiB, WS_O2 = 478 * MiB;
constexpr size_t WS_END = 510 * MiB;
static_assert(WS_W + 4 * W_LAYER == WS_XB && (size_t)NTOK * DFF * 2 <= 3 * BUFB, "ws map");
constexpr int RING_BYTES = 131072, LDS_BYTES = 147456;

__device__ __forceinline__ float wave_sum(float v) {
#pragma unroll
    for (int o = 1; o < 64; o <<= 1) v += __shfl_xor(v, o);
    return v;
}
__device__ __forceinline__ unsigned f2bf(float f) { unsigned u = __builtin_bit_cast(unsigned, f); return (u + 0x7fffu + ((u >> 16) & 1u)) >> 16; }
__device__ __forceinline__ unsigned pk2(float lo, float hi) { return pg8::cvt_pk_bf16(lo, hi); }

template <int MODE>
__device__ __forceinline__ void p0_item(const float* W, int K, int N, bf16u* WT, const float* ks, LAS float* scr, int item, int lane) {
    const int nblk = N / 64, kb = item / nblk, nb = item - kb * nblk, k0 = 64 * kb, n0 = 64 * nb;
    int nn = n0 + lane;
    if (MODE == 1) {
        if (nn < 2048) { const int p = nn & 63; if (p < 16) nn = (nn & ~15) | (p & 3) | ((p & 4) << 1) | ((p & 8) >> 1); }
        else if (nn >= 4096) { const int sec = nn >= 6144 ? 6144 : 4096, r = nn - sec, q = r & 255; nn = sec + ((q >> 7) << 10) + 128 * (r >> 8) + (q & 127); }
    }
    int drow = n0;
    if (MODE == 2) drow = 256 * (n0 >> 7) + (n0 & 127);
    if (MODE == 3) drow = 256 * (n0 >> 7) + 128 + (n0 & 127);
    const float* src = W + (size_t)k0 * N + nn;
    float v[64];
#pragma unroll
    for (int kk = 0; kk < 64; ++kk) v[kk] = src[(size_t)kk * N];
    if (ks) {
#pragma unroll
        for (int kk = 0; kk < 64; ++kk) v[kk] *= ks[k0 + kk];
    }
#pragma unroll
    for (int kk = 0; kk < 64; ++kk) scr[kk * 65 + lane] = v[kk];
    asm volatile("s_waitcnt lgkmcnt(0)" ::: "memory");
    const int c = lane & 7;
#pragma unroll
    for (int j = 0; j < 8; ++j) { const int n = (lane >> 3) + 8 * j; const LAS float* s = scr + (8 * c) * 65 + n;
        v4u o; o.x = pk2(s[0 * 65], s[1 * 65]); o.y = pk2(s[2 * 65], s[3 * 65]); o.z = pk2(s[4 * 65], s[5 * 65]); o.w = pk2(s[6 * 65], s[7 * 65]);
        *(v4u*)(WT + (size_t)(drow + n) * K + k0 + 8 * c) = o; }
    asm volatile("s_waitcnt lgkmcnt(0)" ::: "memory");
}

__device__ __forceinline__ void conv_items(bf16u* BGb, const bf16u* CGb, const float* cw, int vcup, int G) {
    int tidp = threadIdx.x; asm volatile("" : "+v"(tidp));
    const int qd = tidp >> 7, c0 = (tidp & 127) * 8;
    float w0[8], w1[8], w2[8];
#pragma unroll
    for (int e = 0; e < 8; ++e) { w0[e] = cw[c0 + e]; w1[e] = cw[DMOD + c0 + e]; w2[e] = cw[2 * DMOD + c0 + e]; }
    for (int item = vcup * 4 + qd; item < NTOK / 16; item += G * 4) {
        const int r0 = item * 16;
        f32x4 p2a = (f32x4){0.f, 0.f, 0.f, 0.f}, p2b = p2a, p1a = p2a, p1b = p2a;
        if ((r0 & (SEQL - 1)) != 0) {
            unpack8(*(const v4u*)(CGb + (size_t)(r0 - 2) * DMOD + c0), p2a, p2b);
            unpack8(*(const v4u*)(CGb + (size_t)(r0 - 1) * DMOD + c0), p1a, p1b);
        }
        v4u pv[16], bv[16];
#pragma unroll
        for (int i = 0; i < 16; ++i) { const size_t off = (size_t)(r0 + i) * DMOD + c0; pv[i] = *(const v4u*)(CGb + off); bv[i] = *(const v4u*)(BGb + off); }
#pragma unroll
        for (int i = 0; i < 16; ++i) {
            const size_t off = (size_t)(r0 + i) * DMOD + c0;
            f32x4 p0a, p0b, ba, bb;
            unpack8(pv[i], p0a, p0b); unpack8(bv[i], ba, bb);
            f32x4 ya, yb;
#pragma unroll
            for (int e = 0; e < 4; ++e) { ya[e] = ba[e] * (w0[e] * p2a[e] + w1[e] * p1a[e] + w2[e] * p0a[e]); yb[e] = bb[e] * (w0[4 + e] * p2b[e] + w1[4 + e] * p1b[e] + w2[4 + e] * p0b[e]); }
            *(v4u*)(BGb + off) = pack8(ya, yb);
            p2a = p1a; p2b = p1b; p1a = p0a; p1b = p0b;
        }
    }
}

constexpr int I_IN = (DMOD / 64) * (INW / 64), I_SQ = (DMOD / 64) * (DMOD / 64), I_G = (DMOD / 64) * (DFF / 64), I_D = (DFF / 64) * (DMOD / 64);
constexpr int I_LAYER = I_IN + 3 * I_SQ + 2 * I_G + I_D;
#define CONVERT_LAYER(LYR, START, STRIDE, LANE) do { \
        LAS float* scr_ = (LAS float*)(L + wave * 17408); const int l_ = (LYR); unsigned char* wl_ = ws + WS_W + (size_t)l_ * W_LAYER; \
        for (int it_ = (START); it_ < I_LAYER; it_ += (STRIDE)) { int r_ = it_; \
            if (r_ < I_IN) { p0_item<1>(w_in + (size_t)l_ * DMOD * INW, DMOD, INW, (bf16u*)(wl_ + WL_IN), mix_norm + l_ * DMOD, scr_, r_, LANE); continue; } r_ -= I_IN; \
            if (r_ < I_SQ) { p0_item<0>(w_a + (size_t)l_ * DMOD * DMOD, DMOD, DMOD, (bf16u*)(wl_ + WL_A), nullptr, scr_, r_, LANE); continue; } r_ -= I_SQ; \
            if (r_ < I_SQ) { p0_item<0>(w_b + (size_t)l_ * DMOD * DMOD, DMOD, DMOD, (bf16u*)(wl_ + WL_B), nullptr, scr_, r_, LANE); continue; } r_ -= I_SQ; \
            if (r_ < I_SQ) { p0_item<0>(w_o + (size_t)l_ * DMOD * DMOD, DMOD, DMOD, (bf16u*)(wl_ + WL_O), nullptr, scr_, r_, LANE); continue; } r_ -= I_SQ; \
            if (r_ < I_G) { p0_item<2>(w_gate + (size_t)l_ * DMOD * DFF, DMOD, DFF, (bf16u*)(wl_ + WL_GU), ffn_norm + l_ * DMOD, scr_, r_, LANE); continue; } r_ -= I_G; \
            if (r_ < I_G) { p0_item<3>(w_up + (size_t)l_ * DMOD * DFF, DMOD, DFF, (bf16u*)(wl_ + WL_GU), ffn_norm + l_ * DMOD, scr_, r_, LANE); continue; } r_ -= I_G; \
            p0_item<0>(w_down + (size_t)l_ * DFF * DMOD, DFF, DMOD, (bf16u*)(wl_ + WL_D), nullptr, scr_, r_, LANE); \
        } } while (0)

#define REP_SYNC 1
#define REP_P0 1
#define REP_P1 1
#define REP_P3 1
#define REP_P5 1
#define GSYNC() do { for (int r_ = 0; r_ < REP_SYNC; ++r_) xcd_barrier(bar); } while (0)
struct Args { const void* in[18]; float* out; unsigned char* ws; float linit[4]; float freq[8]; };

__global__ void __launch_bounds__(NWAVES * 64, 2) mk_fwd(Args a) {
    extern __shared__ __attribute__((aligned(16))) unsigned char lds[];
    cg::grid_group grid = cg::this_grid();
    LAS unsigned char* L = (LAS unsigned char*)lds;
    const int tid = threadIdx.x, lane = tid & 63, wave = __builtin_amdgcn_readfirstlane(tid >> 6);
    const int G = gridDim.x, bx = blockIdx.x;
    const int vcu = (G % 8 == 0) ? (bx % 8) * (G / 8) + bx / 8 : bx;
    unsigned char* ws = a.ws;
    const float* x_in = (const float*)a.in[0]; const int* positions = (const int*)a.in[1];
    const float* mix_norm = (const float*)a.in[2]; const float* w_in = (const float*)a.in[3];
    const float* lq1 = (const float*)a.in[4]; const float* lk1 = (const float*)a.in[5]; const float* lq2 = (const float*)a.in[6]; const float* lk2 = (const float*)a.in[7];
    const float* subln_w = (const float*)a.in[8]; const float* conv_w = (const float*)a.in[9];
    const float* w_a = (const float*)a.in[10]; const float* w_b = (const float*)a.in[11]; const float* w_o = (const float*)a.in[12];
    const float* ffn_norm = (const float*)a.in[13]; const float* w_gate = (const float*)a.in[14]; const float* w_up = (const float*)a.in[15]; const float* w_down = (const float*)a.in[16];
    const float* final_norm = (const float*)a.in[17];
    float* out = a.out;
    float* rope = (float*)(ws + WS_ROPE); float* ssqA = (float*)(ws + WS_SSQA); float* ssqB = (float*)(ws + WS_SSQB); float* lamtab = (float*)(ws + WS_LAM);
    bf16u* XB = (bf16u*)(ws + WS_XB);
    bf16u* Qb = (bf16u*)(ws + WS_Q); bf16u* Kb = Qb + BUFE; bf16u* Vb = Qb + 2 * BUFE; bf16u* BGb = Qb + 3 * BUFE; bf16u* CGb = Qb + 4 * BUFE; bf16u* Ub = Qb + 5 * BUFE;
    bf16u* SGA = Qb + 6 * BUFE; bf16u* SGB = Qb + 7 * BUFE;
    bf16u* ACT = (bf16u*)(ws + WS_ACT); float* STASH = (float*)(ws + WS_STASH);
    bf16u* O1 = (bf16u*)(ws + WS_O1); bf16u* O2 = (bf16u*)(ws + WS_O2); bf16u* MIXED = O1;
    const int gw = vcu * NWAVES + wave, NGW = G * NWAVES;
    volatile LAS unsigned* MISC = (volatile LAS unsigned*)(L + LDS_BYTES - 64);
    if (tid < 2) MISC[tid] = 0u;
    __syncthreads();
    const XcdBarrier bar = xcd_barrier_post((unsigned*)(ws + WS_BAR), MISC);

#pragma unroll 1
    for (int rep0 = 0; rep0 < REP_P0; ++rep0) {
        CONVERT_LAYER(0, gw, NGW, lane);
        for (int idx = (vcu * NWAVES * 64) + tid; idx < NTOK * 8; idx += G * NWAVES * 64) {
            const int row = idx >> 3, j = idx & 7;
            const float ang = (float)positions[row] * a.freq[j];
            rope[(size_t)row * 16 + j] = cosf(ang); rope[(size_t)row * 16 + 8 + j] = sinf(ang);
        }
        for (int m = gw; m < NTOK; m += NGW) {
            const f32x4* xr = (const f32x4*)(x_in + (size_t)m * DMOD) + lane;
            f32x4 v[4]; float s = 0.f;
#pragma unroll
            for (int j = 0; j < 4; ++j) { v[j] = xr[64 * j]; s += (v[j].x * v[j].x + v[j].y * v[j].y) + (v[j].z * v[j].z + v[j].w * v[j].w); }
            s = wave_sum(s);
            unsigned long long* o8 = (unsigned long long*)(XB + (size_t)m * DMOD) + lane;
#pragma unroll
            for (int j = 0; j < 4; ++j) o8[64 * j] = (unsigned long long)pk2(v[j].x, v[j].y) | ((unsigned long long)pk2(v[j].z, v[j].w) << 32);
            if (lane < 16) ssqA[(size_t)m * 16 + lane] = (lane == 0) ? s : 0.f;
        }
        if (vcu == 0 && wave == 0) {
            for (int l = 0; l < NLAYER; ++l) {
                const float s1 = wave_sum(lq1[l * 64 + lane] * lk1[l * 64 + lane]), s2 = wave_sum(lq2[l * 64 + lane] * lk2[l * 64 + lane]);
                if (lane == 0) lamtab[l] = expf(s1) - expf(s2) + a.linit[l];
            }
        }
    }
    if (a.ws == nullptr) grid.sync();
    GSYNC();

#pragma unroll 1
    for (int l = 0; l < NLAYER; ++l) {
        unsigned char* wl = ws + WS_W + (size_t)l * W_LAYER;
#pragma unroll 1
        for (int rep1 = 0; rep1 < REP_P1; ++rep1) {
            pg8::Gemm g{XB, (const bf16u*)(wl + WL_IN), NTOK, INW, DMOD}; int bxp = bx; asm volatile("" : "+s"(bxp)); pg8::StaticOrder S; S.init(NTOK, INW, G, bxp);
            pg8::Unit u0; int pm0 = -1; if (S.next(0, u0)) pm0 = u0.pm;
            { int tt_ = threadIdx.x; asm volatile("" : "+v"(tt_)); if (pm0 >= 0 && tt_ < 256) ((LAS float*)(L + RING_BYTES))[tt_] = pg8::row_rstd(ssqA, pm0 * 256 + tt_); }
            __syncthreads();
            pg8::EpiProj E{Qb, BUFE, ssqA, rope, attn_body::C2, pm0, (const LAS float*)(L + RING_BYTES)};
            pg8::gemm_phase<pg8::EpiProj, pg8::StaticOrder, true, true>(L, g, S, E);
        }
        GSYNC();
        {
            int vcup = vcu; asm volatile("" : "+s"(vcup));
            const float lam = lamtab[l], osc = 1.0f - a.linit[l];
            const float* sw = subln_w + l * 128;
            const int convslot = (G == 256) ? (vcup & 3) : 0; int ucount = 0; bool conv_done = false;
#pragma unroll 1
            for (int gidx = vcup; gidx < 512; gidx += G) {
                const int gi = gidx >> 8, v = gidx & 255, bh = v >> 3, s = v & 7, qb = gi ? 15 - s : s, b = bh >> 3, h = bh & 7;
#pragma unroll 1
                for (int m = 0; m < 2; ++m) {
                    if (ucount == convslot) { conv_items(BGb, CGb, conv_w + (size_t)l * 3 * DMOD, vcup, G); conv_done = true; }
                    ++ucount;
                    attn_body::attn_unit<8>(b, 2 * h + m, 128 * h, qb, (const attn_body::bf16*)Qb, (const attn_body::bf16*)Kb, (const attn_body::bf16*)Vb, (attn_body::bf16*)(m ? O2 : O1), (char*)lds);
                }
                asm volatile("s_waitcnt vmcnt(0)" ::: "memory");
                int tl_ = threadIdx.x; asm volatile("" : "+v"(tl_)); const int ln = tl_ & 63;
                const int c8 = (ln & 15) * 8;
                const f32x4 sw0 = *(const f32x4*)(sw + c8), sw1 = *(const f32x4*)(sw + c8 + 4);
                const size_t R0 = (size_t)b * SEQL + 256 * qb + 32 * wave;
                const size_t offc = (R0 + (ln >> 4)) * DMOD + 128 * h + c8;
                v4u va[8], vb[8];
#pragma unroll
                for (int it = 0; it < 8; ++it) { va[it] = *(const v4u*)(O1 + offc + (size_t)(4 * it) * DMOD); vb[it] = *(const v4u*)(O2 + offc + (size_t)(4 * it) * DMOD); }
#pragma unroll
                for (int it = 0; it < 8; ++it) {
                    f32x4 a0, a1, b0, b1; unpack8(va[it], a0, a1); unpack8(vb[it], b0, b1);
                    const f32x4 d0 = a0 - b0 * lam, d1 = a1 - b1 * lam;
                    float ss = (d0[0] * d0[0] + d0[1] * d0[1]) + (d0[2] * d0[2] + d0[3] * d0[3]) + (d1[0] * d1[0] + d1[1] * d1[1]) + (d1[2] * d1[2] + d1[3] * d1[3]);
                    ss += pg8::shfl_xor_l(ss, 1, ln); ss += pg8::shfl_xor_l(ss, 2, ln); ss += pg8::shfl_xor_l(ss, 4, ln); ss += pg8::shfl_xor_l(ss, 8, ln);
                    const float rs = osc * __builtin_amdgcn_rsqf(ss * (1.0f / 128.0f) + 1e-6f);
                    *(v4u*)(Qb + offc + (size_t)(4 * it) * DMOD) = pack8(d0 * rs * sw0, d1 * rs * sw1);
                }
            }
            if (!conv_done) conv_items(BGb, CGb, conv_w + (size_t)l * 3 * DMOD, vcup, G);
        }
        GSYNC();
#pragma unroll 1
        for (int rep3 = 0; rep3 < REP_P3; ++rep3) {
            int bxp = bx; asm volatile("" : "+s"(bxp)); pg8::StaticOrder S; S.init(NTOK, DMOD, G, bxp);
            pg8::Gemm g{Qb, (const bf16u*)(wl + WL_A), NTOK, DMOD, DMOD, BGb, (const bf16u*)(wl + WL_B)}; pg8::EpiMix2 E{SGA, SGB, MIXED};
            pg8::gemm_phase<pg8::EpiMix2, pg8::StaticOrder, true, true, true>(L, g, S, E);
        }
        GSYNC();
        {
            pg8::Gemm g{MIXED, (const bf16u*)(wl + WL_O), NTOK, DMOD, DMOD}; int bxp = bx; asm volatile("" : "+s"(bxp)); pg8::StaticOrder S; S.init(NTOK, DMOD, G, bxp);
            pg8::EpiResid E{XB, ssqB};
            pg8::gemm_phase<pg8::EpiResid, pg8::StaticOrder, true, true>(L, g, S, E);
        }
        GSYNC();
#pragma unroll 1
        for (int rep5 = 0; rep5 < REP_P5; ++rep5) {
            pg8::Gemm g{XB, (const bf16u*)(wl + WL_GU), NTOK, 2 * DFF, DMOD}; int bxp = bx; asm volatile("" : "+s"(bxp)); pg8::StaticOrder S; S.init(NTOK, 2 * DFF, G, bxp);
            pg8::Unit u0; int pm0 = -1; if (S.next(0, u0)) pm0 = u0.pm;
            { int tt_ = threadIdx.x; asm volatile("" : "+v"(tt_)); if (pm0 >= 0 && tt_ < 256) ((LAS float*)(L + RING_BYTES))[tt_] = pg8::row_rstd(ssqB, pm0 * 256 + tt_); }
            __syncthreads();
            pg8::EpiSwiGLU E{ACT, DFF, ssqB, pm0, (const LAS float*)(L + RING_BYTES)};
            pg8::gemm_phase<pg8::EpiSwiGLU, pg8::StaticOrder, true, true>(L, g, S, E);
            if (l + 1 < NLAYER && rep5 == 0) {
                const int nwg5 = (NTOK / 256) * (2 * DFF / 256), rem = nwg5 % G;
                const bool light = (rem == 0) || (bxp >= rem);
                if (light) { int tc_ = threadIdx.x; asm volatile("" : "+v"(tc_)); const int lnc = tc_ & 63; const int nl = (rem == 0) ? G : G - rem, li = (rem == 0) ? bxp : bxp - rem;
                    CONVERT_LAYER(l + 1, li * NWAVES + wave, nl * NWAVES, lnc); }
            }
        }
        GSYNC();
        {
            pg8::Gemm g{ACT, (const bf16u*)(wl + WL_D), NTOK, DMOD, DFF}; int bxp = bx; asm volatile("" : "+s"(bxp)); pg8::StaticOrder S; S.init(NTOK, DMOD, G, bxp);
            pg8::EpiResid E{XB, ssqA};
            pg8::gemm_phase<pg8::EpiResid, pg8::StaticOrder, true, true>(L, g, S, E);
        }
        GSYNC();
    }
    int tf_ = threadIdx.x; asm volatile("" : "+v"(tf_)); const int lnf = tf_ & 63;
    for (int m = gw; m < NTOK; m += NGW) {
        const float rstd = row_rstd(ssqA, m);
#pragma unroll
        for (int j = 0; j < 2; ++j) {
            const int c = 8 * lnf + 512 * j;
            f32x4 x0, x1; unpack8(*(const v4u*)(XB + (size_t)m * DMOD + c), x0, x1);
            const f32x4 w0 = *(const f32x4*)(final_norm + c), w1 = *(const f32x4*)(final_norm + c + 4);
            *(f32x4*)(out + (size_t)m * DMOD + c) = x0 * rstd * w0; *(f32x4*)(out + (size_t)m * DMOD + c + 4) = x1 * rstd * w1;
        }
    }
}

extern "C" void kernel_launch(void* const* d_in, const int* in_sizes, int n_in, void* d_out, int out_size, void* d_ws, size_t ws_size, hipStream_t stream) {
    static int grid = 0;
    if (grid == 0) {
        if (n_in != 18 || out_size != NTOK * DMOD || ws_size < WS_END) { fprintf(stderr, "kernel_launch: unexpected shapes (n_in %d, out %d, ws %zu)\n", n_in, out_size, ws_size); grid = -1; return; }
        int dev = 0, cus = 0, per_cu = 0;
        if (hipGetDevice(&dev) != hipSuccess || hipDeviceGetAttribute(&cus, hipDeviceAttributeMultiprocessorCount, dev) != hipSuccess) { grid = -1; return; }
        if (hipFuncSetAttribute((const void*)mk_fwd, hipFuncAttributeMaxDynamicSharedMemorySize, LDS_BYTES) != hipSuccess) { fprintf(stderr, "kernel_launch: hipFuncSetAttribute failed\n"); grid = -1; return; }
        if (hipOccupancyMaxActiveBlocksPerMultiprocessor(&per_cu, (const void*)mk_fwd, NWAVES * 64, LDS_BYTES) != hipSuccess || per_cu < 1) per_cu = 1;
        (void)hipGetLastError();
        grid = cus * per_cu;
    }
    if (grid < 0) return;
    if (hipMemsetAsync((unsigned char*)d_ws + WS_BAR, 0, BAR_ZERO_BYTES, stream) != hipSuccess) { fprintf(stderr, "kernel_launch: memset failed\n"); return; }
    Args a{};
    for (int i = 0; i < 18; ++i) a.in[i] = d_in[i];
    a.out = (float*)d_out; a.ws = (unsigned char*)d_ws;
    for (int l = 0; l < 4; ++l) a.linit[l] = (float)(0.8 - 0.6 * exp(-0.3 * (double)l));
    for (int j = 0; j < 8; ++j) a.freq[j] = (float)pow(500000.0, -(double)j / 8.0);
    void* args[] = {&a};
    hipError_t e = hipLaunchCooperativeKernel((const void*)mk_fwd, dim3(grid), dim3(NWAVES * 64), args, LDS_BYTES, stream);
    if (e != hipSuccess) fprintf(stderr, "kernel_launch: cooperative launch failed: %s (grid %d)\n", hipGetErrorString(e), grid);
}
```
